# Optimizing an MI355X kernel written in HIP

```python
import math
import jax
import jax.numpy as jnp
from jax import lax
import numpy as np

D_MODEL = 1024
BATCH = 8
SEQ = 4096
DEPTH = 4

GRID_W = 64
CTX_LEN = 256
EPS = 1e-6
CONV_DIM = 256
CONV_K = 3
NA_HEADS = 8
NA_HEAD_DIM = 64
NA_DIM = NA_HEADS * NA_HEAD_DIM
WIN_H = 8
WIN_W = 16
SSD_HEADS = 4
SSD_HEAD_DIM = 64
SSD_DIM = SSD_HEADS * SSD_HEAD_DIM
SSD_GROUPS = 2
SSD_STATE = 128
SSD_CONV_K = 3
SSD_CHUNK = 128
XBC_DIM = SSD_DIM + 2 * SSD_GROUPS * SSD_STATE
D_MIX = CONV_DIM + NA_DIM + SSD_DIM
ROPE_BASE = 10000.0
DT_MIN = 1e-3
DT_MAX = 1e-1
IN_SPLITS = (CONV_DIM, CONV_DIM, CONV_DIM, CONV_DIM, NA_DIM, NA_DIM, NA_DIM, NA_DIM, XBC_DIM, SSD_DIM, 2 * SSD_HEADS)
IN_DIM = 4 * CONV_DIM + 4 * NA_DIM + XBC_DIM + SSD_DIM + 2 * SSD_HEADS
F32 = jnp.float32

kernel_name = 'hybrid_conv_natten_ssd_dit'


def rms_norm(x, g):
    xf = x.astype(F32)
    y = xf * lax.rsqrt(jnp.mean(jnp.square(xf), axis=-1, keepdims=True) + EPS)
    return (y * g.astype(F32)).astype(x.dtype)


def depthwise_conv(x, w, b=None):
    k = w.shape[0]
    pad = k // 2
    y = lax.conv_general_dilated(x, w.astype(x.dtype)[:, None, :], window_strides=(1,),
                                 padding=[(pad, k - 1 - pad)],
                                 dimension_numbers=('NWC', 'WIO', 'NWC'),
                                 feature_group_count=x.shape[-1])
    if b is not None:
        y = y + b.astype(x.dtype)
    return y


def split_heads(t, n_heads):
    return t.reshape(*t.shape[:-1], n_heads, t.shape[-1] // n_heads)


def split_projection(u):
    return jnp.split(u, np.cumsum(IN_SPLITS)[:-1].tolist(), axis=-1)


def axial_rope(t, row_pos, col_pos):
    n_freq = t.shape[-1] // 4
    inv_freq = ROPE_BASE ** (-jnp.arange(n_freq, dtype=F32) / n_freq)
    ang = jnp.stack([row_pos[:, None] * inv_freq, col_pos[:, None] * inv_freq], axis=1)
    cos = jnp.cos(ang)[None, :, None]
    sin = jnp.sin(ang)[None, :, None]
    tr = t.astype(F32).reshape(*t.shape[:-1], 2, 2, n_freq)
    t1, t2 = tr[..., 0, :], tr[..., 1, :]
    out = jnp.stack([t1 * cos - t2 * sin, t1 * sin + t2 * cos], axis=-2)
    return out.reshape(t.shape).astype(t.dtype)


def ssd_chunked(xh, dt, a, bh, ch, init_state):
    bsz, seq = xh.shape[:2]
    nc = seq // SSD_CHUNK
    chunk = lambda t: t.astype(F32).reshape(bsz, nc, SSD_CHUNK, *t.shape[2:])
    x_c, dt_c, b_c, c_c = chunk(xh), chunk(dt), chunk(bh), chunk(ch)
    acs = jnp.cumsum(dt_c * a, axis=2)
    lower = jnp.tril(jnp.ones((SSD_CHUNK, SSD_CHUNK), dtype=bool))
    seg = acs[:, :, :, None, :] - acs[:, :, None, :, :]
    decay = jnp.exp(jnp.where(lower[None, None, :, :, None], seg, -jnp.inf))
    mix = jnp.einsum('bcihn,bcjhn->bcijh', c_c, b_c) * decay * dt_c[:, :, None, :, :]
    y_diag = jnp.einsum('bcijh,bcjhp->bcihp', mix, x_c)
    w_end = jnp.exp(acs[:, :, -1:, :] - acs) * dt_c
    states = jnp.einsum('bcjhn,bcjhp->bchpn', b_c * w_end[..., None], x_c)
    chunk_decay = jnp.exp(acs[:, :, -1, :])

    def step(s, inp):
        st, dec = inp
        return s * dec[:, :, None, None] + st, s

    final, prev = lax.scan(step, init_state.astype(F32),
                           (jnp.moveaxis(states, 1, 0), jnp.moveaxis(chunk_decay, 1, 0)))
    prev = jnp.moveaxis(prev, 0, 1)
    y_off = jnp.einsum('bcihn,bchpn->bcihp', c_c * jnp.exp(acs)[..., None], prev)
    return (y_diag + y_off).reshape(bsz, seq, *xh.shape[2:]), final


def ssd_bidirectional(xh, bh, ch, dt_f, dt_b, a_f, a_b, init_f, init_b):
    flip = lambda t: jnp.flip(t, axis=1)
    y_f, fin_f = ssd_chunked(xh, dt_f, a_f, bh, ch, init_f)
    y_b, fin_b = ssd_chunked(flip(xh), flip(dt_b), a_b, flip(bh), flip(ch), init_b)
    return y_f + flip(y_b), fin_f, fin_b


def ssd_inputs(u_xbc, u_dt, conv_w, conv_b, dt_bias_f, dt_bias_b, row_pos=None, col_pos=None):
    xbc = jax.nn.silu(depthwise_conv(u_xbc, conv_w, conv_b))
    xs, bs, cs = jnp.split(xbc, [SSD_DIM, SSD_DIM + SSD_GROUPS * SSD_STATE], axis=-1)
    bs = split_heads(bs, SSD_GROUPS)
    cs = split_heads(cs, SSD_GROUPS)
    if row_pos is not None:
        bs = axial_rope(bs, row_pos, col_pos)
        cs = axial_rope(cs, row_pos, col_pos)
    rep = SSD_HEADS // SSD_GROUPS
    bh = jnp.repeat(bs, rep, axis=2)
    ch = jnp.repeat(cs, rep, axis=2)
    xh = split_heads(xs, SSD_HEADS)
    dt_f = jax.nn.softplus(u_dt[..., :SSD_HEADS].astype(F32) + dt_bias_f.astype(F32))
    dt_b = jax.nn.softplus(u_dt[..., SSD_HEADS:].astype(F32) + dt_bias_b.astype(F32))
    return xh, bh, ch, dt_f, dt_b


def ssd_finish(y, xh, z, ssd_d, norm_w):
    y = y + ssd_d.astype(F32)[:, None] * xh.astype(F32)
    y = y.reshape(*y.shape[:2], SSD_DIM).astype(z.dtype)
    return rms_norm(y * jax.nn.silu(z), norm_w)


def neighborhood_attention(q, k, v, k_ctx, v_ctx, rpb):
    bsz, seq, heads, dh = q.shape
    rows = seq // GRID_W
    kh = min(WIN_H, rows)
    kw = WIN_W
    scale = dh ** -0.5
    qg = q.reshape(bsz, rows, GRID_W, heads, dh)
    kg = k.reshape(bsz, rows, GRID_W, heads, dh)
    vg = v.reshape(bsz, rows, GRID_W, heads, dh)
    cols = jnp.arange(GRID_W)
    col_idx = jnp.clip(cols - kw // 2, 0, GRID_W - kw)[:, None] + jnp.arange(kw)[None, :]
    rpb_cols = rpb[:, :, col_idx - cols[:, None] + (WIN_W - 1)]
    n_win = kh * kw

    def row_block(r):
        r0 = jnp.clip(r - kh // 2, 0, rows - kh)
        q_r = lax.dynamic_index_in_dim(qg, r, axis=1, keepdims=False)
        k_win = lax.dynamic_slice_in_dim(kg, r0, kh, axis=1)[:, :, col_idx]
        v_win = lax.dynamic_slice_in_dim(vg, r0, kh, axis=1)[:, :, col_idx]
        bias = jnp.take(rpb_cols, r0 + jnp.arange(kh) - r + (WIN_H - 1), axis=1)
        s_win = (jnp.einsum('bqhd,biqjhd->bhqij', q_r, k_win).astype(F32) * scale
                 + bias.transpose(0, 2, 1, 3)[None].astype(F32))
        s_ctx = jnp.einsum('bqhd,bkhd->bhqk', q_r, k_ctx).astype(F32) * scale
        s = jnp.concatenate([s_win.reshape(bsz, heads, GRID_W, n_win), s_ctx], axis=-1)
        p = jax.nn.softmax(s, axis=-1).astype(v.dtype)
        p_win = p[..., :n_win].reshape(bsz, heads, GRID_W, kh, kw)
        return (jnp.einsum('bhqij,biqjhd->bqhd', p_win, v_win)
                + jnp.einsum('bhqk,bkhd->bqhd', p[..., n_win:], v_ctx))

    out = lax.map(row_block, jnp.arange(rows))
    return jnp.moveaxis(out, 0, 1).reshape(bsz, seq, heads * dh)


def context_attention(q, k, v):
    s = jnp.einsum('bqhd,bkhd->bhqk', q, k).astype(F32) * (q.shape[-1] ** -0.5)
    p = jax.nn.softmax(s, axis=-1).astype(v.dtype)
    o = jnp.einsum('bhqk,bkhd->bqhd', p, v)
    return o.reshape(*o.shape[:2], NA_DIM)


def merge_project(y_sc, z_sc, y_na, z_na, y_ss, w_out):
    y = jnp.concatenate([y_sc * jax.nn.silu(z_sc), y_na * jax.nn.silu(z_na), y_ss], axis=-1)
    return y @ w_out


def hybrid_layer(x, x_ctx, c, c_ctx, w_ada, b_ada, g_pre, g_post, w_in, conv_a_w, rpb,
                 ssd_conv_w, ssd_conv_b, dt_bias_f, dt_bias_b, a_log_f, a_log_b, ssd_d,
                 ssd_norm_w, w_out, row_pos, col_pos, update_ctx):
    bsz = x.shape[0]
    shift, scale, gate = jnp.split((jax.nn.silu(c) @ w_ada + b_ada)[:, None, :], 3, axis=-1)
    shift_c, scale_c, gate_c = jnp.split(jax.nn.silu(c_ctx) @ w_ada + b_ada, 3, axis=-1)
    h = rms_norm(x, g_pre) * (1 + scale) + shift
    h_c = rms_norm(x_ctx, g_pre) * (1 + scale_c) + shift_c
    (sc_in, sc_b, sc_c, sc_z, na_q, na_k, na_v, na_z, ss_xbc, ss_z, ss_dt) = split_projection(h @ w_in)
    (c_sc_in, c_sc_b, c_sc_c, c_sc_z, c_na_q, c_na_k, c_na_v, c_na_z,
     c_ss_xbc, c_ss_z, c_ss_dt) = split_projection(h_c @ w_in)
    decay_f = -jnp.exp(a_log_f.astype(F32))
    decay_b = -jnp.exp(a_log_b.astype(F32))

    c_xh, c_bh, c_ch, c_dt_f, c_dt_b = ssd_inputs(c_ss_xbc, c_ss_dt, ssd_conv_w, ssd_conv_b, dt_bias_f, dt_bias_b)
    zero_state = jnp.zeros((bsz, SSD_HEADS, SSD_HEAD_DIM, SSD_STATE), F32)
    c_y_ss, fin_f, fin_b = ssd_bidirectional(c_xh, c_bh, c_ch, c_dt_f, c_dt_b, decay_f, decay_b,
                                             zero_state, zero_state)
    c_k = split_heads(c_na_k, NA_HEADS)
    c_v = split_heads(c_na_v, NA_HEADS)

    y_sc = sc_b * depthwise_conv(sc_c * sc_in, conv_a_w)
    y_na = neighborhood_attention(split_heads(na_q, NA_HEADS), split_heads(na_k, NA_HEADS),
                                  split_heads(na_v, NA_HEADS), c_k, c_v, rpb)
    xh, bh, ch, dt_f, dt_b = ssd_inputs(ss_xbc, ss_dt, ssd_conv_w, ssd_conv_b, dt_bias_f, dt_bias_b,
                                        row_pos, col_pos)
    y_ss, _, _ = ssd_bidirectional(xh, bh, ch, dt_f, dt_b, decay_f, decay_b, fin_f, fin_b)
    out = merge_project(y_sc, sc_z, y_na, na_z, ssd_finish(y_ss, xh, ss_z, ssd_d, ssd_norm_w), w_out)
    x = x + gate * rms_norm(out, g_post)

    if update_ctx:
        c_y_sc = c_sc_b * depthwise_conv(c_sc_c * c_sc_in, conv_a_w)
        c_y_na = context_attention(split_heads(c_na_q, NA_HEADS), c_k, c_v)
        c_out = merge_project(c_y_sc, c_sc_z, c_y_na, c_na_z,
                              ssd_finish(c_y_ss, c_xh, c_ss_z, ssd_d, ssd_norm_w), w_out)
        x_ctx = x_ctx + gate_c * rms_norm(c_out, g_post)
    return x, x_ctx


def setup_inputs(seed: int = 0) -> dict:
    key = jax.random.key(seed)
    ks = jax.random.split(key, 24)
    nrm = lambda k, shape, s: jax.random.normal(k, shape, F32) * s

    def dt_bias(k):
        dt = jnp.exp(jax.random.uniform(k, (DEPTH, SSD_HEADS), F32, math.log(DT_MIN), math.log(DT_MAX)))
        return dt + jnp.log(-jnp.expm1(-dt))

    return {
        'x': nrm(ks[0], (BATCH, SEQ, D_MODEL), 1.0),
        'c': nrm(ks[1], (BATCH, D_MODEL), 1.0),
        'ctx': nrm(ks[2], (BATCH, CTX_LEN, D_MODEL), 1.0),
        'c_ctx': nrm(ks[3], (D_MODEL,), 1.0),
        'w_ada': nrm(ks[4], (DEPTH, D_MODEL, 3 * D_MODEL), 0.5 * D_MODEL ** -0.5),
        'b_ada': nrm(ks[5], (DEPTH, 3 * D_MODEL), 0.01),
        'g_pre': 1.0 + nrm(ks[6], (DEPTH, D_MODEL), 0.05),
        'g_post': 1.0 + nrm(ks[7], (DEPTH, D_MODEL), 0.05),
        'w_in': nrm(ks[8], (DEPTH, D_MODEL, IN_DIM), D_MODEL ** -0.5),
        'conv_a_w': nrm(ks[9], (DEPTH, CONV_K, CONV_DIM), CONV_K ** -0.5),
        'rpb': nrm(ks[10], (DEPTH, NA_HEADS, 2 * WIN_H - 1, 2 * WIN_W - 1), 0.1),
        'ssd_conv_w': nrm(ks[11], (DEPTH, SSD_CONV_K, XBC_DIM), SSD_CONV_K ** -0.5),
        'ssd_conv_b': nrm(ks[12], (DEPTH, XBC_DIM), 0.01),
        'dt_bias_f': dt_bias(ks[13]),
        'dt_bias_b': dt_bias(ks[14]),
        'a_log_f': jnp.log(jax.random.uniform(ks[15], (DEPTH, SSD_HEADS), F32, 1.0, 16.0)),
        'a_log_b': jnp.log(jax.random.uniform(ks[16], (DEPTH, SSD_HEADS), F32, 1.0, 16.0)),
        'ssd_d': 1.0 + nrm(ks[17], (DEPTH, SSD_HEADS), 0.05),
        'ssd_norm_w': 1.0 + nrm(ks[18], (DEPTH, SSD_DIM), 0.05),
        'w_out': nrm(ks[19], (DEPTH, D_MIX, D_MODEL), D_MIX ** -0.5),
    }


def reference(x, c, ctx, c_ctx, w_ada, b_ada, g_pre, g_post, w_in, conv_a_w, rpb, ssd_conv_w,
              ssd_conv_b, dt_bias_f, dt_bias_b, a_log_f, a_log_b, ssd_d, ssd_norm_w, w_out):
    pos = jnp.arange(x.shape[1])
    row_pos = (pos // GRID_W).astype(F32)
    col_pos = (pos % GRID_W).astype(F32)
    x_ctx = ctx
    for layer in range(DEPTH):
        x, x_ctx = hybrid_layer(x, x_ctx, c, c_ctx, w_ada[layer], b_ada[layer], g_pre[layer],
                                g_post[layer], w_in[layer], conv_a_w[layer], rpb[layer],
                                ssd_conv_w[layer], ssd_conv_b[layer], dt_bias_f[layer],
                                dt_bias_b[layer], a_log_f[layer], a_log_b[layer], ssd_d[layer],
                                ssd_norm_w[layer], w_out[layer], row_pos, col_pos,
                                layer < DEPTH - 1)
    return x
```

```cpp
#include <hip/hip_runtime.h>
#include <hip/hip_cooperative_groups.h>
#include <cstdio>
namespace cg = cooperative_groups;
namespace pg8 {
#define PG8_LAS __attribute__((address_space(3)))
typedef unsigned short bf16_t;
typedef short bf16x8 __attribute__((ext_vector_type(8)));
typedef float f32x4 __attribute__((ext_vector_type(4)));
typedef unsigned u32x4 __attribute__((ext_vector_type(4)));
constexpr int BM = 256, BK = 64, HALF = 128, HTB = HALF * BK * 2  , STAGE_BYTES = 8 * HTB, NXCD = 8, WGM = 8;

__host__ __device__ __forceinline__ int lds_byte(int r, int c) { const int st = (r >> 4) * 2 + (c >> 5), rr = r & 15, cc = c & 31, ob = rr * 64 + cc * 2; return st * 1024 + (ob ^ (((ob >> 9) & 1) << 5)); }
__host__ __device__ __forceinline__ void stage_rc(int b, int& R, int& C) { const int st = b / 1024, sb = b % 1024, swz = sb ^ (((sb >> 9) & 1) << 5); R = (st >> 1) * 16 + swz / 64; C = (st & 1) * 32 + (swz % 64) / 2; }
__host__ __device__ __forceinline__ int perm32(int rho) { const int n = rho >> 4, i = rho & 15; return 8 * (i >> 2) + 4 * n + (i & 3); }

struct Unit { int pm, pn; };
struct Gemm { const bf16_t* A; const bf16_t* Bt; int M, N, K; };

struct StaticOrder {
    int nM, nN, nwg, G, c;
    __host__ __device__ void init(int M, int N, int G_, int c_) { nM = M / BM; nN = N / BM; nwg = nM * nN; G = G_; c = c_; }
    __host__ __device__ bool next(int i, Unit& u) const {
        const long L = (long)i * G + c; if (L >= nwg) return false;
        int wgid = (int)L; { const int q = nwg / NXCD, r = nwg % NXCD, xcd = wgid % NXCD, off = wgid / NXCD; wgid = (xcd < r ? xcd * (q + 1) : r * (q + 1) + (xcd - r) * q) + off; }
        const int nig = WGM * nN, gid = wgid / nig, fm = gid * WGM, gsz = (nM - fm) < WGM ? (nM - fm) : WGM;
        u.pm = fm + ((wgid % nig) % gsz); u.pn = (wgid % nig) / gsz; return true;
    }
    __device__ __forceinline__ void a_ready(const Unit&) const {}
    __device__ __forceinline__ void done(const Unit&) const {}
};

__device__ __forceinline__ unsigned cvt_pk_bf16(float lo, float hi) { unsigned r; asm volatile("v_cvt_pk_bf16_f32 %0, %1, %2" : "=v"(r) : "v"(lo), "v"(hi)); return r; }
typedef float f32x2 __attribute__((ext_vector_type(2)));
__device__ __forceinline__ f32x2 gelu_pk(f32x2 v) {
    const f32x2 av = __builtin_elementwise_abs(v), d = av * 0.2316418882f + 1.0f;
    f32x2 t; t.x = __builtin_amdgcn_rcpf(d.x); t.y = __builtin_amdgcn_rcpf(d.y);
    f32x2 q = t * 0.5307027145f + (-0.7265760135f); q = q * t + 0.7107068705f; q = q * t + (-0.142248368f); q = q * t + 0.127414796f; q = q * t;
    const f32x2 s = (v * v) * (-0.72134752044f);
    f32x2 e; e.x = __builtin_amdgcn_exp2f(s.x); e.y = __builtin_amdgcn_exp2f(s.y);
    const f32x2 m = v * (q * e), r = v - m;
    f32x2 o; o.x = v.x < 0.f ? m.x : r.x; o.y = v.y < 0.f ? m.y : r.y; return o;
}

struct EpiF32 {
    static constexpr bool PERM = false, AFTER_DRAIN = false;
    float* C; int ldc; const float* bias;
    __device__ __forceinline__ void operator()(const f32x4 (&acc)[2][2][4][2], const Unit& u, int wr, int wc, int fr, int fq) const {
        const int row0 = u.pm * BM + wr * 64 + fr, col0 = u.pn * BM + wc * 32 + 4 * fq;
        f32x4 bv[2][2];
#pragma unroll
        for (int bj = 0; bj < 2; ++bj)
#pragma unroll
            for (int n = 0; n < 2; ++n) bv[bj][n] = bias ? *(const f32x4*)(bias + col0 + bj * HALF + n * 16) : (f32x4){0.f, 0.f, 0.f, 0.f};
#pragma unroll
        for (int ai = 0; ai < 2; ++ai)
#pragma unroll
            for (int m = 0; m < 4; ++m) { float* rowp = C + (size_t)(row0 + ai * HALF + m * 16) * ldc + col0;
#pragma unroll
                for (int bj = 0; bj < 2; ++bj)
#pragma unroll
                    for (int n = 0; n < 2; ++n) *(f32x4*)(rowp + bj * HALF + n * 16) = acc[ai][bj][m][n] + bv[bj][n]; }
    }
};
template <int ACT  > struct EpiBf16 {
    static constexpr bool PERM = true, AFTER_DRAIN = false;
    bf16_t* O; int ldc; const float* bias; int split_cols; size_t split_stride;
    __device__ __forceinline__ void operator()(const f32x4 (&acc)[2][2][4][2], const Unit& u, int wr, int wc, int fr, int fq) const {
        const int row0 = u.pm * BM + wr * 64 + fr; int colt = u.pn * BM; bf16_t* base = O;
        if (split_cols) { const int t = colt / split_cols; base += (size_t)t * split_stride; colt -= t * split_cols; }
        const int col0 = colt + wc * 32 + 8 * fq, bcol0 = u.pn * BM + wc * 32 + 8 * fq;
        f32x4 bv[2][2];
#pragma unroll
        for (int bj = 0; bj < 2; ++bj)
#pragma unroll
            for (int n = 0; n < 2; ++n) bv[bj][n] = bias ? *(const f32x4*)(bias + bcol0 + bj * HALF + 4 * n) : (f32x4){0.f, 0.f, 0.f, 0.f};
#pragma unroll
        for (int ai = 0; ai < 2; ++ai)
#pragma unroll
            for (int m = 0; m < 4; ++m) { bf16_t* rowp = base + (size_t)(row0 + ai * HALF + m * 16) * ldc + col0;
#pragma unroll
                for (int bj = 0; bj < 2; ++bj) { f32x4 v0 = acc[ai][bj][m][0] + bv[bj][0], v1 = acc[ai][bj][m][1] + bv[bj][1];
                    if (ACT == 1) { f32x2 a = gelu_pk((f32x2){v0[0], v0[1]}), b = gelu_pk((f32x2){v0[2], v0[3]}), c = gelu_pk((f32x2){v1[0], v1[1]}), d = gelu_pk((f32x2){v1[2], v1[3]});
                        v0 = (f32x4){a.x, a.y, b.x, b.y}; v1 = (f32x4){c.x, c.y, d.x, d.y}; }
                    if (ACT == 2) {
#pragma unroll
                        for (int j = 0; j < 4; ++j) { v0[j] = 0.5f * v0[j] * (1.0f + erff(v0[j] * 0.70710678f)); v1[j] = 0.5f * v1[j] * (1.0f + erff(v1[j] * 0.70710678f)); } }
                    u32x4 w; w.x = cvt_pk_bf16(v0[0], v0[1]); w.y = cvt_pk_bf16(v0[2], v0[3]); w.z = cvt_pk_bf16(v1[0], v1[1]); w.w = cvt_pk_bf16(v1[2], v1[3]);
                    *(u32x4*)(rowp + bj * HALF) = w; } }
    }
};
template <class Epi, class Sched, bool STAMP = false>
__device__ __forceinline__ void gemm_phase(PG8_LAS unsigned char* lds, const Gemm g, const Sched& S, const Epi& E, unsigned long long* stamps) {
    int tid_l = threadIdx.x; asm volatile("" : "+v"(tid_l)); const int tid = tid_l, wid = __builtin_amdgcn_readfirstlane(tid >> 6), lane = tid & 63, wr = wid >> 2, wc = wid & 3, fr = lane & 15, fq = lane >> 4;
    const int K = g.K, nt = K / BK;
    int ts_lo = 0, ts_hi = 0, nts = 0; const unsigned long long rt_entry = STAMP ? (unsigned long long)wall_clock64() : 0ull;
#define PG8_STAMP() do { if (STAMP && wid == 0 && nts < 64) { const unsigned long long _c = (unsigned long long)clock64(); \
        ts_lo = (lane == nts) ? (int)(unsigned)_c : ts_lo; ts_hi = (lane == nts) ? (int)(unsigned)(_c >> 32) : ts_hi; ++nts; } } while (0)
    PG8_STAMP();
    unsigned voffA[2], voffB[2];
#pragma unroll
    for (int i = 0; i < 2; ++i) { int R, C; stage_rc(tid * 16 + i * 8192, R, C); const int Rb = Epi::PERM ? ((R & ~31) + perm32(R & 31)) : R;
        voffA[i] = (unsigned)(R * K + C) * 2u; voffB[i] = (unsigned)(Rb * K + C) * 2u; }
    const size_t kstep = (size_t)(BK * 2);
    const size_t hstep = (size_t)HALF * K * 2;
    const size_t tstep = 2 * hstep;
    const unsigned ldsw = (unsigned)wid * 1024u;
    const int aoff = lds_byte(wr * 64 + fr, fq * 8), boff = lds_byte(wc * 32 + fr, fq * 8);
#define PG8_SA(b, h) (((b) * 2 + (h)) * HTB)
#define PG8_SB(b, h) ((4 + (b) * 2 + (h)) * HTB)
#define PG8_STAGE(bufoff, gbase, voff) do { _Pragma("unroll") for (int _i = 0; _i < 2; ++_i) \
        __builtin_amdgcn_global_load_lds((const unsigned*)((const char*)(gbase) + (voff)[_i]), (PG8_LAS unsigned*)(lds + (bufoff) + ldsw + _i * 8192), 16, 0, 0); } while (0)
#define PG8_LDA(dst, b, h) do { _Pragma("unroll") for (int m = 0; m < 4; ++m) _Pragma("unroll") for (int k = 0; k < 2; ++k) dst[m][k] = *(const PG8_LAS bf16x8*)(lds + PG8_SA(b, h) + aoff + m * 2048 + k * 1024); } while (0)
#define PG8_LDB(dst, b, h) do { _Pragma("unroll") for (int n = 0; n < 2; ++n) _Pragma("unroll") for (int k = 0; k < 2; ++k) dst[n][k] = *(const PG8_LAS bf16x8*)(lds + PG8_SB(b, h) + boff + n * 2048 + k * 1024); } while (0)
#define PG8_MMA(ai, bj, At, Bt) do { __builtin_amdgcn_s_setprio(1); _Pragma("unroll") for (int m = 0; m < 4; ++m) _Pragma("unroll") for (int n = 0; n < 2; ++n) _Pragma("unroll") for (int k = 0; k < 2; ++k) \
        acc[ai][bj][m][n] = __builtin_amdgcn_mfma_f32_16x16x32_bf16(Bt[n][k], At[m][k], acc[ai][bj][m][n], 0, 0, 0); __builtin_amdgcn_s_setprio(0); } while (0)
#define PG8_WAIT_V(n) asm volatile("s_waitcnt vmcnt(" #n ")" ::: "memory")
#define PG8_WAIT_L(n) asm volatile("s_waitcnt lgkmcnt(" #n ")" ::: "memory")
#define PG8_BAR __builtin_amdgcn_s_barrier()
#define PG8_SCHED __builtin_amdgcn_sched_barrier(0)
    Unit cur, nxt; int ui = 0;
    if (!S.next(0, cur)) return;
    f32x4 acc[2][2][4][2];
#pragma unroll
    for (int a = 0; a < 2; ++a)
#pragma unroll
        for (int b = 0; b < 2; ++b)
#pragma unroll
            for (int m = 0; m < 4; ++m)
#pragma unroll
                for (int n = 0; n < 2; ++n) acc[a][b][m][n] = (f32x4){0.f, 0.f, 0.f, 0.f};
    bf16x8 At[4][2], B0[2][2], B1[2][2];
    const char* cA = (const char*)g.A + (size_t)cur.pm * tstep; const char* cB = (const char*)g.Bt + (size_t)cur.pn * tstep;
    S.a_ready(cur);
    PG8_STAGE(PG8_SB(0, 0), cB, voffB); PG8_STAGE(PG8_SA(0, 0), cA, voffA); PG8_STAGE(PG8_SB(0, 1), cB + hstep, voffB); PG8_STAGE(PG8_SA(0, 1), cA + hstep, voffA);
    if (wr == 1) PG8_BAR;
    PG8_WAIT_V(4); PG8_BAR;
    PG8_STAGE(PG8_SB(1, 0), cB + kstep, voffB); PG8_STAGE(PG8_SA(1, 0), cA + kstep, voffA); PG8_STAGE(PG8_SB(1, 1), cB + hstep + kstep, voffB);
    PG8_WAIT_V(6); PG8_BAR;
    PG8_STAMP();
    for (;;) {
        const bool has_next = S.next(ui + 1, nxt);
        const char* nA = has_next ? (const char*)g.A + (size_t)nxt.pm * tstep : cA; const char* nB = has_next ? (const char*)g.Bt + (size_t)nxt.pn * tstep : cB;
        for (int t = 0; t < nt; t += 2) {
            const bool last = (t == nt - 2);
            const char* a1 = cA + (size_t)(t + 1) * kstep;
            const char* a2 = last ? nA : cA + (size_t)(t + 2) * kstep; const char* b2 = last ? nB : cB + (size_t)(t + 2) * kstep;
            const char* a3 = a2 + kstep; const char* b3 = b2 + kstep;
            if (last && has_next) S.a_ready(nxt);
            PG8_LDB(B0, 0, 0); PG8_SCHED; PG8_LDA(At, 0, 0); PG8_STAGE(PG8_SA(1, 1), a1 + hstep, voffA);
            PG8_WAIT_L(8); PG8_BAR; PG8_WAIT_L(0); PG8_MMA(0, 0, At, B0); PG8_BAR; PG8_SCHED;
            PG8_LDB(B1, 0, 1); PG8_STAGE(PG8_SB(0, 0), b2, voffB);
            PG8_BAR; PG8_WAIT_L(0); PG8_MMA(0, 1, At, B1); PG8_BAR;
            PG8_LDA(At, 0, 1); PG8_STAGE(PG8_SA(0, 0), a2, voffA);
            PG8_BAR; PG8_WAIT_L(0); PG8_MMA(1, 0, At, B0); PG8_BAR; PG8_SCHED;
            PG8_STAGE(PG8_SB(0, 1), b2 + hstep, voffB);
            PG8_WAIT_V(6); PG8_BAR; PG8_MMA(1, 1, At, B1); PG8_BAR;
            PG8_LDB(B0, 1, 0); PG8_SCHED; PG8_LDA(At, 1, 0); PG8_STAGE(PG8_SA(0, 1), a2 + hstep, voffA);
            PG8_WAIT_L(8); PG8_BAR; PG8_WAIT_L(0); PG8_MMA(0, 0, At, B0); PG8_BAR; PG8_SCHED;
            PG8_LDB(B1, 1, 1); PG8_STAGE(PG8_SB(1, 0), b3, voffB);
            PG8_BAR; PG8_WAIT_L(0); PG8_MMA(0, 1, At, B1); PG8_BAR;
            PG8_LDA(At, 1, 1); PG8_STAGE(PG8_SA(1, 0), a3, voffA);
            PG8_BAR; PG8_WAIT_L(0); PG8_MMA(1, 0, At, B0); PG8_BAR; PG8_SCHED;
            PG8_STAGE(PG8_SB(1, 1), b3 + hstep, voffB);
            PG8_WAIT_V(6); PG8_BAR; PG8_MMA(1, 1, At, B1); PG8_BAR;
        }
        PG8_STAMP();
        if constexpr (!Epi::AFTER_DRAIN) { E(acc, cur, wr, wc, fr, fq); S.done(cur); }
        PG8_STAMP();
        if (!has_next) break;
#pragma unroll
        for (int a = 0; a < 2; ++a)
#pragma unroll
            for (int b = 0; b < 2; ++b)
#pragma unroll
                for (int m = 0; m < 4; ++m)
#pragma unroll
                    for (int n = 0; n < 2; ++n) acc[a][b][m][n] = (f32x4){0.f, 0.f, 0.f, 0.f};
        cur = nxt; cA = nA; cB = nB; ++ui;
    }
    PG8_WAIT_V(0);
    if (wr == 0) PG8_BAR;
    PG8_BAR;
    if constexpr (Epi::AFTER_DRAIN) { E.fused(acc, cur, wr, wc, fr, fq, lds, wid, lane); S.done(cur); }
    PG8_STAMP();
    if (STAMP && wid == 0) { stamps[lane] = lane < nts ? (((unsigned long long)(unsigned)ts_hi << 32) | (unsigned)ts_lo) : 0ull;
        if (lane == 62) stamps[62] = rt_entry; if (lane == 63) stamps[63] = (unsigned long long)wall_clock64(); }
#undef PG8_STAMP
#undef PG8_SA
#undef PG8_SB
#undef PG8_STAGE
#undef PG8_LDA
#undef PG8_LDB
#undef PG8_MMA
#undef PG8_WAIT_V
#undef PG8_WAIT_L
#undef PG8_BAR
#undef PG8_SCHED
}
}

#ifndef MK_ONE_LAUNCH
#define MK_ONE_LAUNCH 0
#endif
#define LAS __attribute__((address_space(3)))
typedef unsigned short bf16_t;
typedef short bf16x8 __attribute__((ext_vector_type(8)));
typedef float f32x4 __attribute__((ext_vector_type(4)));
typedef unsigned u32x4 __attribute__((ext_vector_type(4)));
typedef unsigned u32x2 __attribute__((ext_vector_type(2)));

constexpr int DM = 1024, NB = 8, SEQ = 4096, DEPTH = 4, CTXL = 256;
constexpr int TL = NB * SEQ, TCX = NB * CTXL, TT = TL + TCX;
constexpr int INW = 4104, NU = 4096, NCH = 34;
constexpr int U_SCIN = 0, U_SCB = 256, U_SCC = 512, U_SCZ = 768, U_Q = 1024, U_K = 1536, U_V = 2048, U_NAZ = 2560, U_XBC = 3072, U_SSZ = 3840;
constexpr float EPSN = 1e-6f;
constexpr int LDS_BYTES = 150 * 1024;
constexpr int XS_LD = 264;

constexpr size_t MiB = 1u << 20;
constexpr size_t WS_WIN = 0, WS_WOUT = WS_WIN + 8 * MiB, WS_MOD = WS_WOUT + 2 * MiB, WS_H = WS_MOD + 1 * MiB, WS_U = WS_H + 68 * MiB,
                 WS_XBC = WS_U + 272 * MiB, WS_ST = WS_XBC + 51 * MiB, WS_XCTX = WS_ST + 68 * MiB, WS_DTR = WS_XCTX + 8 * MiB,
                 WS_DTS = WS_DTR + 2 * MiB, WS_ACS = WS_DTS + 2 * MiB, WS_CDEC = WS_ACS + 2 * MiB, WS_END = WS_CDEC + 1 * MiB;

struct Args {
    const float* x; const float* c; const float* ctx; const float* c_ctx; const float* w_ada; const float* b_ada; const float* g_pre; const float* g_post;
    const float* w_in; const float* conv_a_w; const float* rpb; const float* ssd_conv_w; const float* ssd_conv_b; const float* dt_bias_f; const float* dt_bias_b;
    const float* a_log_f; const float* a_log_b; const float* ssd_d; const float* ssd_norm_w; const float* w_out;
    float* out; unsigned char* ws; int ph_lo, ph_hi;
};

__device__ __forceinline__ float bf_lo(unsigned w) { return __uint_as_float(w << 16); }
__device__ __forceinline__ float bf_hi(unsigned w) { return __uint_as_float(w & 0xffff0000u); }
__device__ __forceinline__ float bf2f(bf16_t v) { return __uint_as_float(((unsigned)v) << 16); }
__device__ __forceinline__ unsigned pk2(float lo, float hi) { unsigned r; asm volatile("v_cvt_pk_bf16_f32 %0, %1, %2" : "=v"(r) : "v"(lo), "v"(hi)); return r; }
__device__ __forceinline__ bf16_t f2bf(float f) { return (bf16_t)(pk2(f, 0.f) & 0xffffu); }
__device__ __forceinline__ float silu_f(float v) { return v / (1.f + __expf(-v)); }
__device__ __forceinline__ float softplus_f(float v) { return v > 15.f ? v : log1pf(__expf(v)); }
__device__ __forceinline__ f32x4 mfma16(bf16x8 a, bf16x8 b, f32x4 c) { return __builtin_amdgcn_mfma_f32_16x16x32_bf16(a, b, c, 0, 0, 0); }
__device__ __forceinline__ bf16x8 ldg8(const bf16_t* p) { return __builtin_bit_cast(bf16x8, *(const u32x4*)p); }
__device__ __forceinline__ bf16x8 pack8(const float (&f)[8]) { u32x4 v; v.x = pk2(f[0], f[1]); v.y = pk2(f[2], f[3]); v.z = pk2(f[4], f[5]); v.w = pk2(f[6], f[7]); return __builtin_bit_cast(bf16x8, v); }
__device__ __forceinline__ void unpack8(u32x4 v, float (&f)[8]) { f[0] = bf_lo(v.x); f[1] = bf_hi(v.x); f[2] = bf_lo(v.y); f[3] = bf_hi(v.y); f[4] = bf_lo(v.z); f[5] = bf_hi(v.z); f[6] = bf_lo(v.w); f[7] = bf_hi(v.w); }
__device__ __forceinline__ float wave_sum(float v) {
#pragma unroll
    for (int o = 32; o >= 1; o >>= 1) v += __shfl_xor(v, o);
    return v;
}
__device__ __forceinline__ int ltid() { int t = threadIdx.x; asm volatile("" : "+v"(t)); return t; }
__device__ __forceinline__ int chunk_row0(int b, int c) { return c < 2 ? TL + b * CTXL + c * 128 : b * SEQ + (c - 2) * 128; }

__device__ __forceinline__ void phase_adaln(const Args& a, LAS unsigned char* lds) {
    LAS float* sv = (LAS float*)lds;
    LAS float* red = (LAS float*)(lds + 36864);
    float* mod = (float*)(a.ws + WS_MOD);
    const int tid = ltid(), lane = tid & 63, wave = __builtin_amdgcn_readfirstlane(tid >> 6);
    for (int i = tid; i < 9 * 1024; i += 512) { const int r = i >> 10, k = i & 1023; const float v = r < 8 ? a.c[r * 1024 + k] : a.c_ctx[k]; sv[i] = silu_f(v); }
    __syncthreads();
    for (int unit = blockIdx.x; unit < 4 * 48; unit += gridDim.x) {
        const int l = unit / 48, cb = (unit % 48) * 64;
        const float* w = a.w_ada + (size_t)l * 1024 * 3072 + cb + lane;
        float acc[9];
#pragma unroll
        for (int r = 0; r < 9; ++r) acc[r] = 0.f;
#pragma unroll 4
        for (int kk = 0; kk < 128; ++kk) {
            const int k = wave * 128 + kk; const float wv = w[(size_t)k * 3072];
#pragma unroll
            for (int r = 0; r < 9; ++r) acc[r] += sv[r * 1024 + k] * wv;
        }
#pragma unroll
        for (int r = 0; r < 9; ++r) red[(wave * 9 + r) * 64 + lane] = acc[r];
        __syncthreads();
        for (int i = tid; i < 9 * 64; i += 512) {
            const int r = i >> 6, cl = i & 63; float s = 0.f;
#pragma unroll
            for (int w8 = 0; w8 < 8; ++w8) s += red[(w8 * 9 + r) * 64 + cl];
            mod[(l * 9 + r) * 3072 + cb + cl] = s + a.b_ada[l * 3072 + cb + cl];
        }
        __syncthreads();
    }
}

__device__ __forceinline__ void convert_wT(const float* src, int ld, int ncols, bf16_t* dst, LAS unsigned char* lds) {
    LAS bf16_t* tile = (LAS bf16_t*)lds;
    const int tid = ltid();
    const int ntiles = 16 * (ncols / 64);
    for (int ti = blockIdx.x; ti < ntiles; ti += gridDim.x) {
        const int k0 = (ti & 15) * 64, n0 = (ti >> 4) * 64;
        const int r = tid >> 4, c4 = (tid & 15) * 4;
#pragma unroll
        for (int i = 0; i < 2; ++i) {
            const int k = r + 32 * i;
            const float4 v = *(const float4*)(src + (size_t)(k0 + k) * ld + n0 + c4);
            tile[(c4 + 0) * 72 + k] = f2bf(v.x); tile[(c4 + 1) * 72 + k] = f2bf(v.y); tile[(c4 + 2) * 72 + k] = f2bf(v.z); tile[(c4 + 3) * 72 + k] = f2bf(v.w);
        }
        __syncthreads();
        const int n = tid >> 3, ks = (tid & 7) * 8;
        const u32x4 v = *(LAS u32x4*)(tile + n * 72 + ks);
        *(u32x4*)(dst + (size_t)(n0 + n) * 1024 + k0 + ks) = v;
        __syncthreads();
    }
}
__device__ __forceinline__ void convert_layer_weights(const Args& a, LAS unsigned char* lds, int layer) {
    convert_wT(a.w_in + (size_t)layer * 1024 * INW, INW, 4096, (bf16_t*)(a.ws + WS_WIN), lds);
    convert_wT(a.w_out + (size_t)layer * 1024 * 1024, 1024, 1024, (bf16_t*)(a.ws + WS_WOUT), lds);
}

__device__ __forceinline__ void phase_rows(const Args& a, LAS unsigned char* lds, int lpost, int lnorm) {
    LAS float* wdt = (LAS float*)lds;
    const int tid = ltid(), lane = tid & 63, wave = __builtin_amdgcn_readfirstlane(tid >> 6);
    const float* mod = (const float*)(a.ws + WS_MOD);
    const float* outp = (const float*)(a.ws + WS_U);
    float* xctx = (float*)(a.ws + WS_XCTX);
    bf16_t* hb = (bf16_t*)(a.ws + WS_H);
    float* dtr = (float*)(a.ws + WS_DTR);
    if (lnorm >= 0) for (int i = tid; i < 8192; i += 512) wdt[i] = a.w_in[((size_t)lnorm * 1024 + (i >> 3)) * INW + 4096 + (i & 7)];
    __syncthreads();
    for (int row = blockIdx.x * 8 + wave; row < TT; row += gridDim.x * 8) {
        const bool isctx = row >= TL; const int mb = isctx ? 8 : (row >> 12);
        const float* xsrc; float* xdst;
        if (!isctx) { xsrc = (lpost <= 0 ? a.x : (const float*)a.out) + (size_t)row * 1024; xdst = a.out + (size_t)row * 1024; }
        else { xsrc = (lpost <= 0 ? a.ctx : (const float*)xctx) + (size_t)(row - TL) * 1024; xdst = xctx + (size_t)(row - TL) * 1024; }
        float4 xv[4];
#pragma unroll
        for (int j = 0; j < 4; ++j) xv[j] = *(const float4*)(xsrc + j * 256 + lane * 4);
        if (lpost >= 0) {
            const float* o = outp + (size_t)row * 1024; float4 ov[4]; float ss = 0.f;
#pragma unroll
            for (int j = 0; j < 4; ++j) { ov[j] = *(const float4*)(o + j * 256 + lane * 4); ss += ov[j].x * ov[j].x + ov[j].y * ov[j].y + ov[j].z * ov[j].z + ov[j].w * ov[j].w; }
            ss = wave_sum(ss); const float rinv = rsqrtf(ss * (1.f / 1024.f) + EPSN);
            const float* gp = a.g_post + lpost * 1024; const float* gate = mod + (lpost * 9 + mb) * 3072 + 2048;
#pragma unroll
            for (int j = 0; j < 4; ++j) {
                const int e = j * 256 + lane * 4; const float4 g4 = *(const float4*)(gp + e), t4 = *(const float4*)(gate + e);
                xv[j].x += t4.x * (ov[j].x * rinv * g4.x); xv[j].y += t4.y * (ov[j].y * rinv * g4.y); xv[j].z += t4.z * (ov[j].z * rinv * g4.z); xv[j].w += t4.w * (ov[j].w * rinv * g4.w);
                *(float4*)(xdst + e) = xv[j];
            }
        }
        if (lnorm >= 0) {
            float ss = 0.f;
#pragma unroll
            for (int j = 0; j < 4; ++j) ss += xv[j].x * xv[j].x + xv[j].y * xv[j].y + xv[j].z * xv[j].z + xv[j].w * xv[j].w;
            ss = wave_sum(ss); const float rinv = rsqrtf(ss * (1.f / 1024.f) + EPSN);
            const float* shift = mod + (lnorm * 9 + mb) * 3072; const float* scale = shift + 1024; const float* g = a.g_pre + lnorm * 1024;
            float acc[8];
#pragma unroll
            for (int i = 0; i < 8; ++i) acc[i] = 0.f;
#pragma unroll
            for (int j = 0; j < 4; ++j) {
                const int e = j * 256 + lane * 4; const float4 g4 = *(const float4*)(g + e), s4 = *(const float4*)(scale + e), h4 = *(const float4*)(shift + e);
                float hv[4];
                hv[0] = xv[j].x * rinv * g4.x * (1.f + s4.x) + h4.x; hv[1] = xv[j].y * rinv * g4.y * (1.f + s4.y) + h4.y;
                hv[2] = xv[j].z * rinv * g4.z * (1.f + s4.z) + h4.z; hv[3] = xv[j].w * rinv * g4.w * (1.f + s4.w) + h4.w;
                u32x2 pk; pk.x = pk2(hv[0], hv[1]); pk.y = pk2(hv[2], hv[3]);
                *(u32x2*)(hb + (size_t)row * 1024 + e) = pk;
#pragma unroll
                for (int q = 0; q < 4; ++q) {
                    const f32x4 w0 = *(LAS f32x4*)(wdt + (e + q) * 8), w1 = *(LAS f32x4*)(wdt + (e + q) * 8 + 4);
                    acc[0] += hv[q] * w0[0]; acc[1] += hv[q] * w0[1]; acc[2] += hv[q] * w0[2]; acc[3] += hv[q] * w0[3];
                    acc[4] += hv[q] * w1[0]; acc[5] += hv[q] * w1[1]; acc[6] += hv[q] * w1[2]; acc[7] += hv[q] * w1[3];
                }
            }
#pragma unroll
            for (int i = 0; i < 8; ++i) acc[i] = wave_sum(acc[i]);
            if (lane == 0) { *(float4*)(dtr + (size_t)row * 8) = make_float4(acc[0], acc[1], acc[2], acc[3]); *(float4*)(dtr + (size_t)row * 8 + 4) = make_float4(acc[4], acc[5], acc[6], acc[7]); }
        }
    }
}

__device__ __forceinline__ void seq_nb(int t, bool& hasp, bool& hasn) {
    int pos, len; if (t < TL) { pos = t & (SEQ - 1); len = SEQ; } else { pos = (t - TL) & (CTXL - 1); len = CTXL; }
    hasp = pos > 0; hasn = pos < len - 1;
}
__device__ __forceinline__ void ssd_conv8(const bf16_t* u, const float* cw, const float* cb, int t, int ch0, bool hasp, bool hasn, float (&o)[8]) {
    const bf16_t* p = u + (size_t)t * NU + U_XBC + ch0;
    float v0[8], v1[8], v2[8];
    const u32x4 z = {0u, 0u, 0u, 0u};
    unpack8(hasp ? *(const u32x4*)(p - NU) : z, v0); unpack8(*(const u32x4*)p, v1); unpack8(hasn ? *(const u32x4*)(p + NU) : z, v2);
#pragma unroll
    for (int i = 0; i < 8; ++i) { const float s = cw[ch0 + i] * v0[i] + cw[768 + ch0 + i] * v1[i] + cw[1536 + ch0 + i] * v2[i] + cb[ch0 + i]; o[i] = silu_f(s); }
}
__device__ __forceinline__ void phase_prep(const Args& a, LAS unsigned char* lds, int layer) {
    typedef float f32x2 __attribute__((ext_vector_type(2)));
    LAS f32x2* tab = (LAS f32x2*)lds;
    const int tid = ltid();
    const bf16_t* u = (const bf16_t*)(a.ws + WS_U);
    bf16_t* ymix = (bf16_t*)(a.ws + WS_H);
    bf16_t* xbc = (bf16_t*)(a.ws + WS_XBC);
    for (int i = tid; i < 2048; i += 512) {
        const int pos = i >> 5, f = i & 31;
        const float inv = exp2f(-(float)f * 0.41524101186092029f);
        const float ang = (float)pos * inv;
        const float n = rintf(ang * 0.15915494309189535f);
        float rr = fmaf(-n, 6.28125f, ang); rr = fmaf(-n, 0.0019353071795864769f, rr);
        f32x2 cs; cs.x = __cosf(rr); cs.y = __sinf(rr); tab[i] = cs;
    }
    __syncthreads();
    const int gstride = gridDim.x * 512, g0 = blockIdx.x * 512 + tid;
    const float* caw = a.conv_a_w + layer * 768;
    for (int it = g0; it < TT * 32; it += gstride) {
        const int t = it >> 5, ch0 = (it & 31) * 8; bool hasp, hasn; seq_nb(t, hasp, hasn);
        const bf16_t* p = u + (size_t)t * NU + ch0; const u32x4 z = {0u, 0u, 0u, 0u};
        float i0[8], i1[8], i2[8], c0[8], c1[8], c2[8], bb[8], zz[8], o[8];
        unpack8(hasp ? *(const u32x4*)(p + U_SCIN - NU) : z, i0); unpack8(*(const u32x4*)(p + U_SCIN), i1); unpack8(hasn ? *(const u32x4*)(p + U_SCIN + NU) : z, i2);
        unpack8(hasp ? *(const u32x4*)(p + U_SCC - NU) : z, c0); unpack8(*(const u32x4*)(p + U_SCC), c1); unpack8(hasn ? *(const u32x4*)(p + U_SCC + NU) : z, c2);
        unpack8(*(const u32x4*)(p + U_SCB), bb); unpack8(*(const u32x4*)(p + U_SCZ), zz);
#pragma unroll
        for (int i = 0; i < 8; ++i) {
            const float cv = caw[ch0 + i] * (c0[i] * i0[i]) + caw[256 + ch0 + i] * (c1[i] * i1[i]) + caw[512 + ch0 + i] * (c2[i] * i2[i]);
            o[i] = bb[i] * cv * silu_f(zz[i]);
        }
        *(u32x4*)(ymix + (size_t)t * 1024 + ch0) = __builtin_bit_cast(u32x4, pack8(o));
    }
    const float* cw = a.ssd_conv_w + layer * 3 * 768; const float* cb = a.ssd_conv_b + layer * 768;
    for (int it = g0; it < TT * 32; it += gstride) {
        const int t = it >> 5, ch0 = (it & 31) * 8; bool hasp, hasn; seq_nb(t, hasp, hasn);
        float o[8]; ssd_conv8(u, cw, cb, t, ch0, hasp, hasn, o);
        *(u32x4*)(xbc + (size_t)t * 768 + ch0) = __builtin_bit_cast(u32x4, pack8(o));
    }
    for (int it = g0; it < TT * 32; it += gstride) {
        const int t = it >> 5, ru = it & 31, blk = ru >> 2, sub = ru & 3; bool hasp, hasn; seq_nb(t, hasp, hasn);
        const int chA = 256 + blk * 64 + sub * 8, chB = chA + 32;
        float t1[8], t2[8]; ssd_conv8(u, cw, cb, t, chA, hasp, hasn, t1); ssd_conv8(u, cw, cb, t, chB, hasp, hasn, t2);
        if (t < TL) {
            const int l = t & (SEQ - 1); const int pos = (blk & 1) ? (l & 63) : (l >> 6);
#pragma unroll
            for (int i = 0; i < 8; ++i) { const f32x2 cs = tab[pos * 32 + sub * 8 + i]; const float x1 = t1[i], x2 = t2[i]; t1[i] = x1 * cs.x - x2 * cs.y; t2[i] = x1 * cs.y + x2 * cs.x; }
        }
        *(u32x4*)(xbc + (size_t)t * 768 + chA) = __builtin_bit_cast(u32x4, pack8(t1));
        *(u32x4*)(xbc + (size_t)t * 768 + chB) = __builtin_bit_cast(u32x4, pack8(t2));
    }
    const float* dtr = (const float*)(a.ws + WS_DTR); float* dts = (float*)(a.ws + WS_DTS);
    for (int it = g0; it < TT * 8; it += gstride) {
        const int j = it & 7; const float bias = j < 4 ? a.dt_bias_f[layer * 4 + j] : a.dt_bias_b[layer * 4 + j - 4];
        dts[it] = softplus_f(dtr[it] + bias);
    }
}

__device__ __forceinline__ void phase_s1(const Args& a, LAS unsigned char* lds, int layer) {
    LAS bf16_t* xs = (LAS bf16_t*)lds;
    LAS bf16_t* bs = xs + 128 * XS_LD;
    LAS float* wl = (LAS float*)(lds + 2 * 128 * XS_LD * 2);
    const int tid = ltid(), lane = tid & 63, wave = __builtin_amdgcn_readfirstlane(tid >> 6), r16 = lane & 15, quad = lane >> 4;
    const bf16_t* xbc = (const bf16_t*)(a.ws + WS_XBC);
    const float* dts = (const float*)(a.ws + WS_DTS); float* acs = (float*)(a.ws + WS_ACS); float* cdec = (float*)(a.ws + WS_CDEC); float* st = (float*)(a.ws + WS_ST);
    const int h = wave >> 1, dir = wave & 1, g = h >> 1;
    const float a_h = -__expf(dir ? a.a_log_b[layer * 4 + h] : a.a_log_f[layer * 4 + h]);
    for (int unit = blockIdx.x; unit < NB * NCH; unit += gridDim.x) {
        const int b = unit / NCH, c = unit % NCH, row0 = chunk_row0(b, c);
        {
            const int i0 = dir ? 127 - 2 * lane : 2 * lane, i1 = dir ? 126 - 2 * lane : 2 * lane + 1;
            const float d0 = dts[(size_t)(row0 + i0) * 8 + dir * 4 + h], d1 = dts[(size_t)(row0 + i1) * 8 + dir * 4 + h];
            const float v0 = d0 * a_h, v1 = d1 * a_h, tot = v0 + v1; float incl = tot;
#pragma unroll
            for (int o = 1; o < 64; o <<= 1) { const float tv = __shfl_up(incl, o); if (lane >= o) incl += tv; }
            const float excl = incl - tot, c0 = excl + v0, c1 = excl + tot, total = __shfl(incl, 63);
            acs[(size_t)(row0 + i0) * 8 + dir * 4 + h] = c0; acs[(size_t)(row0 + i1) * 8 + dir * 4 + h] = c1;
            wl[wave * 128 + i0] = __expf(total - c0) * d0; wl[wave * 128 + i1] = __expf(total - c1) * d1;
            if (lane == 0) cdec[((b * NCH + c) * 4 + h) * 2 + dir] = __expf(total);
        }
        for (int i = tid; i < 8192; i += 512) {
            const int j = i >> 6, seg = i & 63; const u32x4 v = *(const u32x4*)(xbc + (size_t)(row0 + j) * 768 + seg * 8);
            if (seg < 32) *(LAS u32x4*)(xs + j * XS_LD + seg * 8) = v; else *(LAS u32x4*)(bs + j * XS_LD + (seg - 32) * 8) = v;
        }
        __syncthreads();
        bf16x8 A[4][4];
#pragma unroll
        for (int pt = 0; pt < 4; ++pt)
#pragma unroll
            for (int js = 0; js < 4; ++js) {
                float f[8];
#pragma unroll
                for (int s = 0; s < 8; ++s) { const int j = js * 32 + quad * 8 + s; f[s] = bf2f(xs[j * XS_LD + h * 64 + pt * 16 + r16]) * wl[wave * 128 + j]; }
                A[pt][js] = pack8(f);
            }
        float* stp = st + (size_t)(((b * NCH + c) * 4 + h) * 2 + dir) * 8192;
#pragma unroll 1
        for (int nt = 0; nt < 8; ++nt) {
            f32x4 acc[4];
#pragma unroll
            for (int pt = 0; pt < 4; ++pt) acc[pt] = (f32x4){0.f, 0.f, 0.f, 0.f};
#pragma unroll
            for (int js = 0; js < 4; ++js) {
                bf16x8 bv;
#pragma unroll
                for (int s = 0; s < 8; ++s) { const int j = js * 32 + quad * 8 + s; bv[s] = (short)bs[j * XS_LD + g * 128 + nt * 16 + r16]; }
#pragma unroll
                for (int pt = 0; pt < 4; ++pt) acc[pt] = mfma16(A[pt][js], bv, acc[pt]);
            }
#pragma unroll
            for (int pt = 0; pt < 4; ++pt)
#pragma unroll
                for (int jj = 0; jj < 4; ++jj) stp[(pt * 16 + quad * 4 + jj) * 128 + nt * 16 + r16] = acc[pt][jj];
        }
        __syncthreads();
    }
}

__device__ __forceinline__ void phase_scan(const Args& a) {
    float* st = (float*)(a.ws + WS_ST); const float* cdec = (const float*)(a.ws + WS_CDEC);
    const int tid_ = ltid();
    for (int it = blockIdx.x * 512 + tid_; it < 64 * 2048; it += gridDim.x * 512) {
        const int bhd = it >> 11, e4 = it & 2047, b = bhd >> 3, h = (bhd >> 1) & 3, dir = bhd & 1;
        float4 s = make_float4(0.f, 0.f, 0.f, 0.f);
#pragma unroll 2
        for (int step = 0; step < NCH; ++step) {
            const int c = dir ? (step < 2 ? 1 - step : 35 - step) : step;
            const int sidx = ((b * NCH + c) * 4 + h) * 2 + dir;
            float4* p = (float4*)(st + (size_t)sidx * 8192) + e4;
            const float4 v = *p; const float dec = cdec[sidx];
            *p = s;
            s.x = s.x * dec + v.x; s.y = s.y * dec + v.y; s.z = s.z * dec + v.z; s.w = s.w * dec + v.w;
        }
    }
}

template <bool WIN>
__device__ __forceinline__ void attn_unit(const Args& a, int layer, int b, int r, int jc, int qb, int h, int lane) {
    const bf16_t* u = (const bf16_t*)(a.ws + WS_U); bf16_t* ymix = (bf16_t*)(a.ws + WS_H);
    const int r16 = lane & 15, quad = lane >> 4;
    const int qrow0 = WIN ? b * SEQ + r * 64 + jc * 16 : TL + b * CTXL + qb * 16;
    const int r0 = WIN ? min(max(r - 4, 0), 56) : 0;
    const int cbase = WIN ? (jc == 0 ? 0 : (jc == 1 ? 8 : (jc == 2 ? 24 : 32))) : 0;
    const int winrow0 = b * SEQ + r0 * 64 + cbase, ctxrow0 = TL + b * CTXL;
    constexpr int NT = WIN ? 32 : 16, WT = WIN ? 16 : 0;
    const bf16_t* qp = u + (size_t)(qrow0 + r16) * NU + U_Q + h * 64 + quad * 8;
    const bf16x8 qf0 = ldg8(qp), qf1 = ldg8(qp + 32);
    f32x4 S[NT];
#pragma unroll
    for (int t = 0; t < NT; ++t) {
        int krow;
        if (t < WT) { const int kk = t * 16 + r16; krow = winrow0 + (kk >> 5) * 64 + (kk & 31); } else krow = ctxrow0 + (t - WT) * 16 + r16;
        const bf16_t* kp = u + (size_t)krow * NU + U_K + h * 64 + quad * 8;
        f32x4 acc = {0.f, 0.f, 0.f, 0.f};
        acc = mfma16(ldg8(kp), qf0, acc); acc = mfma16(ldg8(kp + 32), qf1, acc);
        S[t] = acc;
    }
    const int cq = jc * 16 + r16, c0 = min(max(cq - 8, 0), 48);
    const float* rp = a.rpb + (size_t)(layer * 8 + h) * 15 * 31;
    float mx = -1e30f;
#pragma unroll
    for (int t = 0; t < NT; ++t)
#pragma unroll
        for (int jj = 0; jj < 4; ++jj) {
            float s = S[t][jj] * 0.125f;
            if (t < WT) {
                const int ki = t >> 1, col = cbase + (t & 1) * 16 + quad * 4 + jj; const bool valid = (col >= c0) && (col < c0 + 16);
                const int ri = r0 + ki - r + 7, ci = min(max(col - cq + 15, 0), 30);
                const float bias = rp[ri * 31 + ci];
                s = valid ? s + bias : -1e30f;
            }
            S[t][jj] = s; mx = fmaxf(mx, s);
        }
    mx = fmaxf(mx, __shfl_xor(mx, 16)); mx = fmaxf(mx, __shfl_xor(mx, 32));
    float sum = 0.f;
#pragma unroll
    for (int t = 0; t < NT; ++t)
#pragma unroll
        for (int jj = 0; jj < 4; ++jj) { const float p = __expf(S[t][jj] - mx); S[t][jj] = p; sum += p; }
    sum += __shfl_xor(sum, 16); sum += __shfl_xor(sum, 32);
    const float inv = 1.f / sum;
    f32x4 O[4];
#pragma unroll
    for (int db = 0; db < 4; ++db) O[db] = (f32x4){0.f, 0.f, 0.f, 0.f};
#pragma unroll
    for (int kb = 0; kb < NT / 2; ++kb) {
        u32x4 pw; pw.x = pk2(S[2 * kb][0], S[2 * kb][1]); pw.y = pk2(S[2 * kb][2], S[2 * kb][3]); pw.z = pk2(S[2 * kb + 1][0], S[2 * kb + 1][1]); pw.w = pk2(S[2 * kb + 1][2], S[2 * kb + 1][3]);
        const bf16x8 pb = __builtin_bit_cast(bf16x8, pw);
        const bf16_t* vp[8];
#pragma unroll
        for (int s = 0; s < 8; ++s) {
            const int t = 2 * kb + (s >> 2), kin = quad * 4 + (s & 3); int krow;
            if (t < WT) { const int kk = t * 16 + kin; krow = winrow0 + (kk >> 5) * 64 + (kk & 31); } else krow = ctxrow0 + (t - WT) * 16 + kin;
            vp[s] = u + (size_t)krow * NU + U_V + h * 64 + r16;
        }
#pragma unroll
        for (int db = 0; db < 4; ++db) {
            bf16x8 av;
#pragma unroll
            for (int s = 0; s < 8; ++s) av[s] = (short)vp[s][db * 16];
            O[db] = mfma16(av, pb, O[db]);
        }
    }
    const size_t orow = (size_t)(qrow0 + r16);
#pragma unroll
    for (int db = 0; db < 4; ++db) {
        const int ch = h * 64 + db * 16 + quad * 4;
        const u32x2 zz = *(const u32x2*)(u + orow * NU + U_NAZ + ch);
        const float y0 = O[db][0] * inv * silu_f(bf_lo(zz.x)), y1 = O[db][1] * inv * silu_f(bf_hi(zz.x)), y2 = O[db][2] * inv * silu_f(bf_lo(zz.y)), y3 = O[db][3] * inv * silu_f(bf_hi(zz.y));
        u32x2 o; o.x = pk2(y0, y1); o.y = pk2(y2, y3);
        *(u32x2*)(ymix + orow * 1024 + 256 + ch) = o;
    }
}
__device__ __forceinline__ void phase_attn(const Args& a, int layer) {
    const int tid = ltid(), lane = tid & 63, wave = __builtin_amdgcn_readfirstlane(tid >> 6);
    const int nunits = 2048 + (layer < DEPTH - 1 ? 128 : 0);
    for (int unit = blockIdx.x; unit < nunits; unit += gridDim.x) {
        if (unit < 2048) attn_unit<true>(a, layer, unit >> 8, (unit >> 2) & 63, unit & 3, 0, wave, lane);
        else { const int uu = unit - 2048; attn_unit<false>(a, layer, uu >> 4, 0, 0, uu & 15, wave, lane); }
    }
}

template <int G>
__device__ __forceinline__ void s3_group(const Args& a, int layer, u32x2 (&Y)[4][4], f32x4& ssv, LAS const bf16_t* xs, LAS const float* arr, const bf16_t* u, const bf16_t* xbc, const float* st,
                                         int b, int c, int row0, int wave, int r16, int quad) {
    const int iop = wave * 16 + r16;
    bf16x8 cf[4];
#pragma unroll
    for (int ks = 0; ks < 4; ++ks) cf[ks] = ldg8(xbc + (size_t)(row0 + iop) * 768 + 512 + G * 128 + ks * 32 + quad * 8);
    f32x4 accd[2][4];
#pragma unroll
    for (int hh = 0; hh < 2; ++hh)
#pragma unroll
        for (int pt = 0; pt < 4; ++pt) accd[hh][pt] = (f32x4){0.f, 0.f, 0.f, 0.f};
    LAS const float* dtf0 = arr + (0 * 4 + G * 2) * 128; LAS const float* dtb0 = arr + (1 * 4 + G * 2) * 128;
    LAS const float* af0 = arr + (2 * 4 + G * 2) * 128; LAS const float* ab0 = arr + (3 * 4 + G * 2) * 128;
#pragma unroll 1
    for (int jb = 0; jb < 4; ++jb) {
        f32x4 GT2[2];
#pragma unroll
        for (int t2 = 0; t2 < 2; ++t2) {
            f32x4 acc = {0.f, 0.f, 0.f, 0.f};
            const bf16_t* bp = xbc + (size_t)(row0 + (2 * jb + t2) * 16 + r16) * 768 + 256 + G * 128 + quad * 8;
#pragma unroll
            for (int ks = 0; ks < 4; ++ks) acc = mfma16(ldg8(bp + ks * 32), cf[ks], acc);
            GT2[t2] = acc;
        }
#pragma unroll
        for (int hh = 0; hh < 2; ++hh) {
            LAS const float* dtf = dtf0 + hh * 128; LAS const float* dtb = dtb0 + hh * 128; LAS const float* af = af0 + hh * 128; LAS const float* ab = ab0 + hh * 128;
            const float aif = af[iop], aib = ab[iop];
            float f[8];
#pragma unroll
            for (int s = 0; s < 8; ++s) {
                const int j = (2 * jb + (s >> 2)) * 16 + quad * 4 + (s & 3);
                const bool fw = j < iop;
                const float e = fw ? aif - af[j] : aib - ab[j];
                float m = (fw ? dtf[j] : dtb[j]) * __expf(fminf(e, 0.f));
                if (j == iop) m = dtf[j] + dtb[j];
                f[s] = GT2[s >> 2][s & 3] * m;
            }
            const bf16x8 aop = pack8(f);
#pragma unroll
            for (int pt = 0; pt < 4; ++pt) {
                bf16x8 bop;
#pragma unroll
                for (int s = 0; s < 8; ++s) { const int j = (2 * jb + (s >> 2)) * 16 + quad * 4 + (s & 3); bop[s] = (short)xs[j * XS_LD + (G * 2 + hh) * 64 + pt * 16 + r16]; }
                accd[hh][pt] = mfma16(aop, bop, accd[hh][pt]);
            }
        }
    }
#pragma unroll
    for (int hh = 0; hh < 2; ++hh) {
        const int h = G * 2 + hh;
#pragma unroll
        for (int dir = 0; dir < 2; ++dir) {
            const float* pp = st + (size_t)(((b * NCH + c) * 4 + h) * 2 + dir) * 8192;
            const float ei = __expf(arr[((2 + dir) * 4 + h) * 128 + iop]);
#pragma unroll
            for (int ks = 0; ks < 4; ++ks) {
                float cfv[8]; unpack8(__builtin_bit_cast(u32x4, cf[ks]), cfv);
#pragma unroll
                for (int s = 0; s < 8; ++s) cfv[s] *= ei;
                const bf16x8 aop = pack8(cfv);
#pragma unroll
                for (int pt = 0; pt < 4; ++pt) {
                    const float* q = pp + (pt * 16 + r16) * 128 + ks * 32 + quad * 8;
                    const float4 v0 = *(const float4*)q, v1 = *(const float4*)(q + 4);
                    u32x4 w; w.x = pk2(v0.x, v0.y); w.y = pk2(v0.z, v0.w); w.z = pk2(v1.x, v1.y); w.w = pk2(v1.z, v1.w);
                    accd[hh][pt] = mfma16(aop, __builtin_bit_cast(bf16x8, w), accd[hh][pt]);
                }
                asm volatile("" ::: "memory");
            }
        }
        const float dh = a.ssd_d[layer * 4 + h];
#pragma unroll
        for (int pt = 0; pt < 4; ++pt) {
            f32x4 yv;
#pragma unroll
            for (int jj = 0; jj < 4; ++jj) {
                const int io = wave * 16 + quad * 4 + jj, ch = h * 64 + pt * 16 + r16;
                const float y = accd[hh][pt][jj] + dh * bf2f(xs[io * XS_LD + ch]);
                const float z = bf2f(u[(size_t)(row0 + io) * NU + U_SSZ + ch]);
                yv[jj] = y * silu_f(z);
            }
            ssv += yv * yv;
            u32x2 pk; pk.x = pk2(yv[0], yv[1]); pk.y = pk2(yv[2], yv[3]);
            Y[h][pt] = pk;
        }
    }
}
__device__ __forceinline__ void phase_s3(const Args& a, LAS unsigned char* lds, int layer) {
    LAS bf16_t* xs = (LAS bf16_t*)lds;
    LAS float* arr = (LAS float*)(lds + 128 * XS_LD * 2);
    const int tid = ltid(), lane = tid & 63, wave = __builtin_amdgcn_readfirstlane(tid >> 6), r16 = lane & 15, quad = lane >> 4;
    const bf16_t* u = (const bf16_t*)(a.ws + WS_U); bf16_t* ymix = (bf16_t*)(a.ws + WS_H);
    const bf16_t* xbc = (const bf16_t*)(a.ws + WS_XBC);
    const float* dts = (const float*)(a.ws + WS_DTS); const float* acs = (const float*)(a.ws + WS_ACS); const float* st = (const float*)(a.ws + WS_ST);
    const int cfirst = (layer == DEPTH - 1) ? 2 : 0, ncu = NCH - cfirst;
#pragma unroll 1
    for (int unit = blockIdx.x; unit < NB * ncu; unit += gridDim.x) {
        const int b = unit / ncu, c = cfirst + unit % ncu, row0 = chunk_row0(b, c);
        for (int i = tid; i < 4096; i += 512) { const int j = i >> 5, seg = i & 31; *(LAS u32x4*)(xs + j * XS_LD + seg * 8) = *(const u32x4*)(xbc + (size_t)(row0 + j) * 768 + seg * 8); }
        for (int i = tid; i < 1024; i += 512) {
            const int j = i >> 3, col = i & 7;
            arr[((col < 4 ? 0 : 1) * 4 + (col & 3)) * 128 + j] = dts[(size_t)(row0 + j) * 8 + col];
            arr[((col < 4 ? 2 : 3) * 4 + (col & 3)) * 128 + j] = acs[(size_t)(row0 + j) * 8 + col];
        }
        __syncthreads();
        u32x2 Y[4][4];
        f32x4 ssv = {0.f, 0.f, 0.f, 0.f};
        s3_group<0>(a, layer, Y, ssv, xs, arr, u, xbc, st, b, c, row0, wave, r16, quad);
        s3_group<1>(a, layer, Y, ssv, xs, arr, u, xbc, st, b, c, row0, wave, r16, quad);
        f32x4 rinv;
#pragma unroll
        for (int jj = 0; jj < 4; ++jj) {
            float ss = ssv[jj];
            ss += __shfl_xor(ss, 1); ss += __shfl_xor(ss, 2); ss += __shfl_xor(ss, 4); ss += __shfl_xor(ss, 8);
            rinv[jj] = rsqrtf(ss * (1.f / 256.f) + EPSN);
        }
        const float* nw = a.ssd_norm_w + layer * 256;
#pragma unroll
        for (int h = 0; h < 4; ++h)
#pragma unroll
            for (int pt = 0; pt < 4; ++pt) {
                const int ch = h * 64 + pt * 16 + r16; const float w = nw[ch];
#pragma unroll
                for (int jj = 0; jj < 4; ++jj) {
                    const int io = wave * 16 + quad * 4 + jj; const unsigned pw = (jj < 2) ? Y[h][pt].x : Y[h][pt].y; const float yv = (jj & 1) ? bf_hi(pw) : bf_lo(pw);
                    ymix[(size_t)(row0 + io) * 1024 + 768 + ch] = f2bf(yv * rinv[jj] * w);
                }
            }
        __syncthreads();
    }
}

constexpr int PH_PER_LAYER = 7, N_PHASES = 2 + PH_PER_LAYER * DEPTH;
__device__ __forceinline__ void run_phase(const Args& a, LAS unsigned char* lds, int ph) {
    if (ph == 0) { phase_adaln(a, lds); convert_layer_weights(a, lds, 0); return; }
    if (ph == 1) { phase_rows(a, lds, -1, 0); return; }
    const int layer = (ph - 2) / PH_PER_LAYER, k = (ph - 2) % PH_PER_LAYER;
    if (k == 0) {
        pg8::Gemm g{(const pg8::bf16_t*)(a.ws + WS_H), (const pg8::bf16_t*)(a.ws + WS_WIN), TT, NU, DM}; pg8::StaticOrder S; S.init(TT, NU, (int)gridDim.x, (int)blockIdx.x);
        pg8::EpiBf16<0> E{(pg8::bf16_t*)(a.ws + WS_U), NU, nullptr, 0, 0};
        pg8::gemm_phase<pg8::EpiBf16<0>, pg8::StaticOrder>(lds, g, S, E, nullptr);
    } else if (k == 1) phase_prep(a, lds, layer);
    else if (k == 2) phase_s1(a, lds, layer);
    else if (k == 3) { phase_scan(a); phase_attn(a, layer); }
    else if (k == 4) phase_s3(a, lds, layer);
    else if (k == 5) {
        pg8::Gemm g{(const pg8::bf16_t*)(a.ws + WS_H), (const pg8::bf16_t*)(a.ws + WS_WOUT), TT, DM, DM}; pg8::StaticOrder S; S.init(TT, DM, (int)gridDim.x, (int)blockIdx.x);
        pg8::EpiF32 E{(float*)(a.ws + WS_U), DM, nullptr};
        pg8::gemm_phase<pg8::EpiF32, pg8::StaticOrder>(lds, g, S, E, nullptr);
    } else {
        phase_rows(a, lds, layer, layer + 1 < DEPTH ? layer + 1 : -1);
        if (layer + 1 < DEPTH) { __syncthreads(); convert_layer_weights(a, lds, layer + 1); }
    }
}

template <bool COOP>
__global__ void __launch_bounds__(512) mk_fwd(Args a) {
    extern __shared__ __attribute__((aligned(16))) unsigned char lds_raw[];
    LAS unsigned char* lds = (LAS unsigned char*)lds_raw;
    for (int ph = a.ph_lo; ph < a.ph_hi; ++ph) {
        run_phase(a, lds, ph);
        if (COOP) { if (ph + 1 < a.ph_hi) cg::this_grid().sync(); }
        else __syncthreads();
    }
}

extern "C" void kernel_launch(void* const* d_in, const int* in_sizes, int n_in, void* d_out, int out_size, void* d_ws, size_t ws_size, hipStream_t stream) {
    static int grid = 0;
    if (grid == 0) {
        if (n_in != 20 || ws_size < WS_END) { fprintf(stderr, "kernel_launch: unexpected n_in %d or ws_size %zu (< %zu)\n", n_in, ws_size, (size_t)WS_END); grid = -1; return; }
        int dev = 0, cus = 0, per_cu = 0;
        hipGetDevice(&dev); hipDeviceGetAttribute(&cus, hipDeviceAttributeMultiprocessorCount, dev);
        hipFuncSetAttribute((const void*)mk_fwd<true>, hipFuncAttributeMaxDynamicSharedMemorySize, LDS_BYTES);
        hipFuncSetAttribute((const void*)mk_fwd<false>, hipFuncAttributeMaxDynamicSharedMemorySize, LDS_BYTES);
        hipOccupancyMaxActiveBlocksPerMultiprocessor(&per_cu, (const void*)mk_fwd<true>, 512, LDS_BYTES);
        if (per_cu < 1) { fprintf(stderr, "kernel_launch: occupancy query reports %d blocks per CU\n", per_cu); per_cu = 1; }
        (void)hipGetLastError();
        grid = cus * 1;
        if (grid <= 0) grid = 256;
    }
    if (grid < 0) return;
    Args a{};
    a.x = (const float*)d_in[0]; a.c = (const float*)d_in[1]; a.ctx = (const float*)d_in[2]; a.c_ctx = (const float*)d_in[3]; a.w_ada = (const float*)d_in[4];
    a.b_ada = (const float*)d_in[5]; a.g_pre = (const float*)d_in[6]; a.g_post = (const float*)d_in[7]; a.w_in = (const float*)d_in[8]; a.conv_a_w = (const float*)d_in[9];
    a.rpb = (const float*)d_in[10]; a.ssd_conv_w = (const float*)d_in[11]; a.ssd_conv_b = (const float*)d_in[12]; a.dt_bias_f = (const float*)d_in[13];
    a.dt_bias_b = (const float*)d_in[14]; a.a_log_f = (const float*)d_in[15]; a.a_log_b = (const float*)d_in[16]; a.ssd_d = (const float*)d_in[17];
    a.ssd_norm_w = (const float*)d_in[18]; a.w_out = (const float*)d_in[19];
    a.out = (float*)d_out; a.ws = (unsigned char*)d_ws;
#if MK_ONE_LAUNCH
    a.ph_lo = 0; a.ph_hi = N_PHASES;
    void* args[] = {&a};
    hipError_t e = hipLaunchCooperativeKernel((const void*)mk_fwd<true>, dim3(grid), dim3(512), args, LDS_BYTES, stream);
    if (e != hipSuccess) fprintf(stderr, "cooperative launch failed: %s (grid %d)\n", hipGetErrorString(e), grid);
#else
    for (int ph = 0; ph < N_PHASES; ++ph) {
        a.ph_lo = ph; a.ph_hi = ph + 1;
        hipLaunchKernelGGL(mk_fwd<false>, dim3(grid), dim3(512), LDS_BYTES, stream, a);
    }
#endif
}
```

```cpp
#include <hip/hip_runtime.h>
#include <hip/hip_cooperative_groups.h>
#include <cstdio>
namespace cg = cooperative_groups;
namespace pg8 {
#define PG8_LAS __attribute__((address_space(3)))
typedef unsigned short bf16_t;
typedef short bf16x8 __attribute__((ext_vector_type(8)));
typedef float f32x4 __attribute__((ext_vector_type(4)));
typedef unsigned u32x4 __attribute__((ext_vector_type(4)));
constexpr int BM = 256, BK = 64, HALF = 128, HTB = HALF * BK * 2  , STAGE_BYTES = 8 * HTB, NXCD = 8, WGM = 8;

__host__ __device__ __forceinline__ int lds_byte(int r, int c) { const int st = (r >> 4) * 2 + (c >> 5), rr = r & 15, cc = c & 31, ob = rr * 64 + cc * 2; return st * 1024 + (ob ^ (((ob >> 9) & 1) << 5)); }
__host__ __device__ __forceinline__ void stage_rc(int b, int& R, int& C) { const int st = b / 1024, sb = b % 1024, swz = sb ^ (((sb >> 9) & 1) << 5); R = (st >> 1) * 16 + swz / 64; C = (st & 1) * 32 + (swz % 64) / 2; }
__host__ __device__ __forceinline__ int perm32(int rho) { const int n = rho >> 4, i = rho & 15; return 8 * (i >> 2) + 4 * n + (i & 3); }

struct Unit { int pm, pn; };
struct Gemm { const bf16_t* A; const bf16_t* Bt; int M, N, K; };

struct StaticOrder {
    int nM, nN, nwg, G, c;
    __host__ __device__ void init(int M, int N, int G_, int c_) { nM = M / BM; nN = N / BM; nwg = nM * nN; G = G_; c = c_; }
    __host__ __device__ bool next(int i, Unit& u) const {
        const long L = (long)i * G + c; if (L >= nwg) return false;
        int wgid = (int)L; { const int q = nwg / NXCD, r = nwg % NXCD, xcd = wgid % NXCD, off = wgid / NXCD; wgid = (xcd < r ? xcd * (q + 1) : r * (q + 1) + (xcd - r) * q) + off; }
        const int nig = WGM * nN, gid = wgid / nig, fm = gid * WGM, gsz = (nM - fm) < WGM ? (nM - fm) : WGM;
        u.pm = fm + ((wgid % nig) % gsz); u.pn = (wgid % nig) / gsz; return true;
    }
    __device__ __forceinline__ void a_ready(const Unit&) const {}
    __device__ __forceinline__ void done(const Unit&) const {}
};

typedef float f32x2c __attribute__((ext_vector_type(2))); typedef __bf16 bf16x2c __attribute__((ext_vector_type(2)));
__device__ __forceinline__ unsigned cvt_pk_bf16(float lo, float hi) { const f32x2c v = {lo, hi}; return __builtin_bit_cast(unsigned, __builtin_convertvector(v, bf16x2c)); }
typedef float f32x2 __attribute__((ext_vector_type(2)));
__device__ __forceinline__ f32x2 gelu_pk(f32x2 v) {
    const f32x2 av = __builtin_elementwise_abs(v), d = av * 0.2316418882f + 1.0f;
    f32x2 t; t.x = __builtin_amdgcn_rcpf(d.x); t.y = __builtin_amdgcn_rcpf(d.y);
    f32x2 q = t * 0.5307027145f + (-0.7265760135f); q = q * t + 0.7107068705f; q = q * t + (-0.142248368f); q = q * t + 0.127414796f; q = q * t;
    const f32x2 s = (v * v) * (-0.72134752044f);
    f32x2 e; e.x = __builtin_amdgcn_exp2f(s.x); e.y = __builtin_amdgcn_exp2f(s.y);
    const f32x2 m = v * (q * e), r = v - m;
    f32x2 o; o.x = v.x < 0.f ? m.x : r.x; o.y = v.y < 0.f ? m.y : r.y; return o;
}

struct EpiF32 {
    static constexpr bool PERM = false, AFTER_DRAIN = false;
    float* C; int ldc; const float* bias;
    __device__ __forceinline__ void operator()(const f32x4 (&acc)[2][2][4][2], const Unit& u, int wr, int wc, int fr, int fq) const {
        const int row0 = u.pm * BM + wr * 64 + fr, col0 = u.pn * BM + wc * 32 + 4 * fq;
        f32x4 bv[2][2];
#pragma unroll
        for (int bj = 0; bj < 2; ++bj)
#pragma unroll
            for (int n = 0; n < 2; ++n) bv[bj][n] = bias ? *(const f32x4*)(bias + col0 + bj * HALF + n * 16) : (f32x4){0.f, 0.f, 0.f, 0.f};
#pragma unroll
        for (int ai = 0; ai < 2; ++ai)
#pragma unroll
            for (int m = 0; m < 4; ++m) { float* rowp = C + (size_t)(row0 + ai * HALF + m * 16) * ldc + col0;
#pragma unroll
                for (int bj = 0; bj < 2; ++bj)
#pragma unroll
                    for (int n = 0; n < 2; ++n) *(f32x4*)(rowp + bj * HALF + n * 16) = acc[ai][bj][m][n] + bv[bj][n]; }
    }
};
template <int ACT  > struct EpiBf16 {
    static constexpr bool PERM = true, AFTER_DRAIN = false;
    bf16_t* O; int ldc; const float* bias; int split_cols; size_t split_stride;
    __device__ __forceinline__ void operator()(const f32x4 (&acc)[2][2][4][2], const Unit& u, int wr, int wc, int fr, int fq) const {
        const int row0 = u.pm * BM + wr * 64 + fr; int colt = u.pn * BM; bf16_t* base = O;
        if (split_cols) { const int t = colt / split_cols; base += (size_t)t * split_stride; colt -= t * split_cols; }
        const int col0 = colt + wc * 32 + 8 * fq, bcol0 = u.pn * BM + wc * 32 + 8 * fq;
        f32x4 bv[2][2];
#pragma unroll
        for (int bj = 0; bj < 2; ++bj)
#pragma unroll
            for (int n = 0; n < 2; ++n) bv[bj][n] = bias ? *(const f32x4*)(bias + bcol0 + bj * HALF + 4 * n) : (f32x4){0.f, 0.f, 0.f, 0.f};
#pragma unroll
        for (int ai = 0; ai < 2; ++ai)
#pragma unroll
            for (int m = 0; m < 4; ++m) { bf16_t* rowp = base + (size_t)(row0 + ai * HALF + m * 16) * ldc + col0;
#pragma unroll
                for (int bj = 0; bj < 2; ++bj) { f32x4 v0 = acc[ai][bj][m][0] + bv[bj][0], v1 = acc[ai][bj][m][1] + bv[bj][1];
                    if (ACT == 1) { f32x2 a = gelu_pk((f32x2){v0[0], v0[1]}), b = gelu_pk((f32x2){v0[2], v0[3]}), c = gelu_pk((f32x2){v1[0], v1[1]}), d = gelu_pk((f32x2){v1[2], v1[3]});
                        v0 = (f32x4){a.x, a.y, b.x, b.y}; v1 = (f32x4){c.x, c.y, d.x, d.y}; }
                    if (ACT == 2) {
#pragma unroll
                        for (int j = 0; j < 4; ++j) { v0[j] = 0.5f * v0[j] * (1.0f + erff(v0[j] * 0.70710678f)); v1[j] = 0.5f * v1[j] * (1.0f + erff(v1[j] * 0.70710678f)); } }
                    u32x4 w; w.x = cvt_pk_bf16(v0[0], v0[1]); w.y = cvt_pk_bf16(v0[2], v0[3]); w.z = cvt_pk_bf16(v1[0], v1[1]); w.w = cvt_pk_bf16(v1[2], v1[3]);
                    *(u32x4*)(rowp + bj * HALF) = w; } }
    }
};
template <class Epi, class Sched, bool STAMP = false>
__device__ __forceinline__ void gemm_phase(PG8_LAS unsigned char* lds, const Gemm g, const Sched& S, const Epi& E, unsigned long long* stamps) {
    int tid_l = threadIdx.x; asm volatile("" : "+v"(tid_l)); const int tid = tid_l, wid = __builtin_amdgcn_readfirstlane(tid >> 6), lane = tid & 63, wr = wid >> 2, wc = wid & 3, fr = lane & 15, fq = lane >> 4;
    const int K = g.K, nt = K / BK;
    int ts_lo = 0, ts_hi = 0, nts = 0; const unsigned long long rt_entry = STAMP ? (unsigned long long)wall_clock64() : 0ull;
#define PG8_STAMP() do { if (STAMP && wid == 0 && nts < 64) { const unsigned long long _c = (unsigned long long)clock64(); \
        ts_lo = (lane == nts) ? (int)(unsigned)_c : ts_lo; ts_hi = (lane == nts) ? (int)(unsigned)(_c >> 32) : ts_hi; ++nts; } } while (0)
    PG8_STAMP();
    unsigned voffA[2], voffB[2];
#pragma unroll
    for (int i = 0; i < 2; ++i) { int R, C; stage_rc(tid * 16 + i * 8192, R, C); const int Rb = Epi::PERM ? ((R & ~31) + perm32(R & 31)) : R;
        voffA[i] = (unsigned)(R * K + C) * 2u; voffB[i] = (unsigned)(Rb * K + C) * 2u; }
    const size_t kstep = (size_t)(BK * 2);
    const size_t hstep = (size_t)HALF * K * 2;
    const size_t tstep = 2 * hstep;
    const unsigned ldsw = (unsigned)wid * 1024u;
    const int aoff = lds_byte(wr * 64 + fr, fq * 8), boff = lds_byte(wc * 32 + fr, fq * 8);
#define PG8_SA(b, h) (((b) * 2 + (h)) * HTB)
#define PG8_SB(b, h) ((4 + (b) * 2 + (h)) * HTB)
#define PG8_STAGE(bufoff, gbase, voff) do { _Pragma("unroll") for (int _i = 0; _i < 2; ++_i) \
        __builtin_amdgcn_global_load_lds((const unsigned*)((const char*)(gbase) + (voff)[_i]), (PG8_LAS unsigned*)(lds + (bufoff) + ldsw + _i * 8192), 16, 0, 0); } while (0)
#define PG8_LDA(dst, b, h) do { _Pragma("unroll") for (int m = 0; m < 4; ++m) _Pragma("unroll") for (int k = 0; k < 2; ++k) dst[m][k] = *(const PG8_LAS bf16x8*)(lds + PG8_SA(b, h) + aoff + m * 2048 + k * 1024); } while (0)
#define PG8_LDB(dst, b, h) do { _Pragma("unroll") for (int n = 0; n < 2; ++n) _Pragma("unroll") for (int k = 0; k < 2; ++k) dst[n][k] = *(const PG8_LAS bf16x8*)(lds + PG8_SB(b, h) + boff + n * 2048 + k * 1024); } while (0)
#define PG8_MMA(ai, bj, At, Bt) do { __builtin_amdgcn_s_setprio(1); _Pragma("unroll") for (int m = 0; m < 4; ++m) _Pragma("unroll") for (int n = 0; n < 2; ++n) _Pragma("unroll") for (int k = 0; k < 2; ++k) \
        acc[ai][bj][m][n] = __builtin_amdgcn_mfma_f32_16x16x32_bf16(Bt[n][k], At[m][k], acc[ai][bj][m][n], 0, 0, 0); __builtin_amdgcn_s_setprio(0); } while (0)
#define PG8_WAIT_V(n) asm volatile("s_waitcnt vmcnt(" #n ")" ::: "memory")
#define PG8_WAIT_L(n) asm volatile("s_waitcnt lgkmcnt(" #n ")" ::: "memory")
#define PG8_BAR __builtin_amdgcn_s_barrier()
#define PG8_SCHED __builtin_amdgcn_sched_barrier(0)
    Unit cur, nxt; int ui = 0;
    if (!S.next(0, cur)) return;
    f32x4 acc[2][2][4][2];
#pragma unroll
    for (int a = 0; a < 2; ++a)
#pragma unroll
        for (int b = 0; b < 2; ++b)
#pragma unroll
            for (int m = 0; m < 4; ++m)
#pragma unroll
                for (int n = 0; n < 2; ++n) acc[a][b][m][n] = (f32x4){0.f, 0.f, 0.f, 0.f};
    bf16x8 At[4][2], B0[2][2], B1[2][2];
    const char* cA = (const char*)g.A + (size_t)cur.pm * tstep; const char* cB = (const char*)g.Bt + (size_t)cur.pn * tstep;
    S.a_ready(cur);
    PG8_STAGE(PG8_SB(0, 0), cB, voffB); PG8_STAGE(PG8_SA(0, 0), cA, voffA); PG8_STAGE(PG8_SB(0, 1), cB + hstep, voffB); PG8_STAGE(PG8_SA(0, 1), cA + hstep, voffA);
    if (wr == 1) PG8_BAR;
    PG8_WAIT_V(4); PG8_BAR;
    PG8_STAGE(PG8_SB(1, 0), cB + kstep, voffB); PG8_STAGE(PG8_SA(1, 0), cA + kstep, voffA); PG8_STAGE(PG8_SB(1, 1), cB + hstep + kstep, voffB);
    PG8_WAIT_V(6); PG8_BAR;
    PG8_STAMP();
    for (;;) {
        const bool has_next = S.next(ui + 1, nxt);
        const char* nA = has_next ? (const char*)g.A + (size_t)nxt.pm * tstep : cA; const char* nB = has_next ? (const char*)g.Bt + (size_t)nxt.pn * tstep : cB;
        for (int t = 0; t < nt; t += 2) {
            const bool last = (t == nt - 2);
            const char* a1 = cA + (size_t)(t + 1) * kstep;
            const char* a2 = last ? nA : cA + (size_t)(t + 2) * kstep; const char* b2 = last ? nB : cB + (size_t)(t + 2) * kstep;
            const char* a3 = a2 + kstep; const char* b3 = b2 + kstep;
            if (last && has_next) S.a_ready(nxt);
            PG8_LDB(B0, 0, 0); PG8_SCHED; PG8_LDA(At, 0, 0); PG8_STAGE(PG8_SA(1, 1), a1 + hstep, voffA);
            PG8_WAIT_L(8); PG8_BAR; PG8_WAIT_L(0); PG8_MMA(0, 0, At, B0); PG8_BAR; PG8_SCHED;
            PG8_LDB(B1, 0, 1); PG8_STAGE(PG8_SB(0, 0), b2, voffB);
            PG8_BAR; PG8_WAIT_L(0); PG8_MMA(0, 1, At, B1); PG8_BAR;
            PG8_LDA(At, 0, 1); PG8_STAGE(PG8_SA(0, 0), a2, voffA);
            PG8_BAR; PG8_WAIT_L(0); PG8_MMA(1, 0, At, B0); PG8_BAR; PG8_SCHED;
            PG8_STAGE(PG8_SB(0, 1), b2 + hstep, voffB);
            PG8_WAIT_V(6); PG8_BAR; PG8_MMA(1, 1, At, B1); PG8_BAR;
            PG8_LDB(B0, 1, 0); PG8_SCHED; PG8_LDA(At, 1, 0); PG8_STAGE(PG8_SA(0, 1), a2 + hstep, voffA);
            PG8_WAIT_L(8); PG8_BAR; PG8_WAIT_L(0); PG8_MMA(0, 0, At, B0); PG8_BAR; PG8_SCHED;
            PG8_LDB(B1, 1, 1); PG8_STAGE(PG8_SB(1, 0), b3, voffB);
            PG8_BAR; PG8_WAIT_L(0); PG8_MMA(0, 1, At, B1); PG8_BAR;
            PG8_LDA(At, 1, 1); PG8_STAGE(PG8_SA(1, 0), a3, voffA);
            PG8_BAR; PG8_WAIT_L(0); PG8_MMA(1, 0, At, B0); PG8_BAR; PG8_SCHED;
            PG8_STAGE(PG8_SB(1, 1), b3 + hstep, voffB);
            PG8_WAIT_V(6); PG8_BAR; PG8_MMA(1, 1, At, B1); PG8_BAR;
        }
        PG8_STAMP();
        if constexpr (!Epi::AFTER_DRAIN) { E(acc, cur, wr, wc, fr, fq); S.done(cur); }
        PG8_STAMP();
        if (!has_next) break;
#pragma unroll
        for (int a = 0; a < 2; ++a)
#pragma unroll
            for (int b = 0; b < 2; ++b)
#pragma unroll
                for (int m = 0; m < 4; ++m)
#pragma unroll
                    for (int n = 0; n < 2; ++n) acc[a][b][m][n] = (f32x4){0.f, 0.f, 0.f, 0.f};
        cur = nxt; cA = nA; cB = nB; ++ui;
    }
    PG8_WAIT_V(0);
    if (wr == 0) PG8_BAR;
    PG8_BAR;
    if constexpr (Epi::AFTER_DRAIN) { E.fused(acc, cur, wr, wc, fr, fq, lds, wid, lane); S.done(cur); }
    PG8_STAMP();
    if (STAMP && wid == 0) { stamps[lane] = lane < nts ? (((unsigned long long)(unsigned)ts_hi << 32) | (unsigned)ts_lo) : 0ull;
        if (lane == 62) stamps[62] = rt_entry; if (lane == 63) stamps[63] = (unsigned long long)wall_clock64(); }
#undef PG8_STAMP
#undef PG8_SA
#undef PG8_SB
#undef PG8_STAGE
#undef PG8_LDA
#undef PG8_LDB
#undef PG8_MMA
#undef PG8_WAIT_V
#undef PG8_WAIT_L
#undef PG8_BAR
#undef PG8_SCHED
}
}

#ifndef MK_ONE_LAUNCH
#define MK_ONE_LAUNCH 1
#endif
#define LAS __attribute__((address_space(3)))
typedef unsigned short bf16_t;
typedef short bf16x8 __attribute__((ext_vector_type(8)));
typedef short s16x4 __attribute__((ext_vector_type(4)));
typedef float f32x4 __attribute__((ext_vector_type(4)));
typedef unsigned u32x4 __attribute__((ext_vector_type(4)));
typedef unsigned u32x2 __attribute__((ext_vector_type(2)));

#define XB_TMO      128
#define XB_XCNT(j)  (256  + 64 * (j))
#define XB_XSUB(j)  (1280 + 64 * (j))
#define XB_XGEN(j)  (2304 + 64 * (j))
#define XB_TOP      3328
#define XB_TOPGEN   3392
#define XCD_BAR_WORDS 3456
#define XB_SPIN_CAP (1u << 18)

__device__ __forceinline__ unsigned xb_ld(unsigned* p)              { return __hip_atomic_load(p, __ATOMIC_RELAXED, __HIP_MEMORY_SCOPE_AGENT); }
__device__ __forceinline__ unsigned xb_add(unsigned* p, unsigned v) { return __hip_atomic_fetch_add(p, v, __ATOMIC_RELAXED, __HIP_MEMORY_SCOPE_AGENT); }
__device__ __forceinline__ unsigned xb_xcc_id() { return (unsigned)__builtin_amdgcn_s_getreg((3 << 11) | 20) & 0xFu; }
#define XB_SPIN(cond, bar) do { unsigned _sp = 0; while (cond) { __builtin_amdgcn_s_sleep(1); \
    if ((++_sp & 255u) == 0u) { if (xb_ld(&(bar)[XB_TMO])) break; if (_sp > XB_SPIN_CAP) { atomicAdd(&(bar)[XB_TMO], 1u); break; } } } } while (0)

struct XcdBarrier {
    unsigned* bar; unsigned x;
    volatile LAS unsigned* st;
};

__device__ __forceinline__ XcdBarrier xcd_barrier_post(unsigned* bar, volatile LAS unsigned* st) {
    XcdBarrier b; b.bar = bar; b.x = xb_xcc_id(); b.st = st;
    if (threadIdx.x == 0) (void)xb_add(&bar[XB_XCNT(b.x)], 1u);
    return b;
}
__device__ __forceinline__ void xcd_barrier_complete(unsigned* bar, unsigned x, unsigned& nloc, unsigned& nx) {
    const unsigned G = gridDim.x * gridDim.y * gridDim.z;
    unsigned sum, cnt, mine, sp = 0u;
    for (;;) {
        sum = 0u; cnt = 0u; mine = 0u;
#pragma unroll
        for (unsigned j = 0; j < 16; ++j) { const unsigned c = xb_ld(&bar[XB_XCNT(j)]); sum += c; cnt += (c > 0u) ? 1u : 0u; mine = (j == x) ? c : mine; }
        if (sum == G) break;
        __builtin_amdgcn_s_sleep(1);
        if ((++sp & 255u) == 0u) { if (xb_ld(&bar[XB_TMO])) break; if (sp > XB_SPIN_CAP) { atomicAdd(&bar[XB_TMO], 1u); break; } }
    }
    nloc = mine > 0u ? mine : 1u; nx = cnt > 0u ? cnt : 1u;
}

__device__ __forceinline__ void xcd_barrier(const XcdBarrier& b) {
    asm volatile("s_waitcnt vmcnt(0)" ::: "memory");
    __syncthreads();
    if (threadIdx.x == 0) {
        unsigned* bar = b.bar;
        __builtin_amdgcn_s_waitcnt(0);
        unsigned nloc = b.st[0], nx = b.st[1];
        if (nloc == 0u) { xcd_barrier_complete(bar, b.x, nloc, nx); b.st[0] = nloc; b.st[1] = nx; }
        const unsigned old = xb_add(&bar[XB_XSUB(b.x)], 1u);
        const unsigned gen = old / nloc;
        if (old + 1u == (gen + 1u) * nloc) {
            __builtin_amdgcn_fence(__ATOMIC_RELEASE, "agent");
            asm volatile("s_waitcnt vmcnt(0)" ::: "memory");
            const unsigned og = xb_add(&bar[XB_TOP], 1u);
            const unsigned tg = og / nx;
            if (og + 1u == (tg + 1u) * nx) xb_add(&bar[XB_TOPGEN], 1u);
            else XB_SPIN(xb_ld(&bar[XB_TOPGEN]) == tg, bar);
            __builtin_amdgcn_fence(__ATOMIC_ACQUIRE, "agent");
            xb_add(&bar[XB_XGEN(b.x)], 1u);
            asm volatile("s_waitcnt vmcnt(0)" ::: "memory");
        } else {
            XB_SPIN(xb_ld(&bar[XB_XGEN(b.x)]) == gen, bar);
            __builtin_amdgcn_fence(__ATOMIC_ACQUIRE, "agent");
            asm volatile("s_waitcnt vmcnt(0)" ::: "memory");
        }
    }
    __syncthreads();
}

constexpr int DM = 1024, NB = 8, SEQ = 4096, DEPTH = 4, CTXL = 256;
constexpr int TL = NB * SEQ, TCX = NB * CTXL, TT = TL + TCX;
constexpr int INW = 4104, NU = 4096, ULD = 3584, VLD = 4096, NCH = 34;
constexpr int U_SCIN = 0, U_SCB = 256, U_SCC = 512, U_SCZ = 768, U_Q = 1024, U_V = 1536, U_NAZ = 2048, U_XBC = 2560, U_SSZ = 3328;
constexpr float EPSN = 1e-6f;
constexpr int NB_ = 8;
constexpr int LDS_BYTES = 150 * 1024;
constexpr int XS_LD = 272;
constexpr size_t VT_CTX = (size_t)NB_ * 8 * 64 * VLD;
constexpr size_t KB_CTX = (size_t)NB_ * 8 * 128 * 2048;

constexpr size_t MiB = 1u << 20;
constexpr size_t WS_WIN = 0, WS_WOUT = WS_WIN + 8 * MiB, WS_MOD = WS_WOUT + 2 * MiB, WS_H = WS_MOD + 1 * MiB, WS_U = WS_H + 68 * MiB,
                 WS_KB = WS_U + 238 * MiB, WS_XBC = WS_U + 277 * MiB, WS_ST = WS_XBC + 51 * MiB, WS_VT = WS_ST + 34 * MiB, WS_XCTX = WS_VT + 36 * MiB, WS_DTR = WS_XCTX + 8 * MiB,
                 WS_DTS = WS_DTR + 2 * MiB, WS_ACS = WS_DTS + 2 * MiB, WS_CDEC = WS_ACS + 2 * MiB, WS_BAR = WS_CDEC + 1 * MiB, WS_END = WS_BAR + 1 * MiB;

struct Args {
    const float* x; const float* c; const float* ctx; const float* c_ctx; const float* w_ada; const float* b_ada; const float* g_pre; const float* g_post;
    const float* w_in; const float* conv_a_w; const float* rpb; const float* ssd_conv_w; const float* ssd_conv_b; const float* dt_bias_f; const float* dt_bias_b;
    const float* a_log_f; const float* a_log_b; const float* ssd_d; const float* ssd_norm_w; const float* w_out;
    float* out; unsigned char* ws; int ph_lo, ph_hi;
};

__device__ __forceinline__ float bf_lo(unsigned w) { return __uint_as_float(w << 16); }
__device__ __forceinline__ float bf_hi(unsigned w) { return __uint_as_float(w & 0xffff0000u); }
__device__ __forceinline__ float bf2f(bf16_t v) { return __uint_as_float(((unsigned)v) << 16); }
typedef float f32x2_t __attribute__((ext_vector_type(2)));
typedef __bf16 bf16x2_t __attribute__((ext_vector_type(2)));
__device__ __forceinline__ unsigned pk2(float lo, float hi) { const f32x2_t v = {lo, hi}; return __builtin_bit_cast(unsigned, __builtin_convertvector(v, bf16x2_t)); }
__device__ __forceinline__ bf16_t f2bf(float f) { return (bf16_t)(pk2(f, 0.f) & 0xffffu); }
__device__ __forceinline__ float silu_f(float v) { return v / (1.f + __expf(-v)); }
__device__ __forceinline__ float softplus_f(float v) { return v > 15.f ? v : log1pf(__expf(v)); }
__device__ __forceinline__ f32x4 mfma16(bf16x8 a, bf16x8 b, f32x4 c) { return __builtin_amdgcn_mfma_f32_16x16x32_bf16(a, b, c, 0, 0, 0); }
__device__ __forceinline__ bf16x8 ldg8(const bf16_t* p) { return __builtin_bit_cast(bf16x8, *(const u32x4*)p); }
__device__ __forceinline__ bf16x8 pack8(const float (&f)[8]) { u32x4 v; v.x = pk2(f[0], f[1]); v.y = pk2(f[2], f[3]); v.z = pk2(f[4], f[5]); v.w = pk2(f[6], f[7]); return __builtin_bit_cast(bf16x8, v); }
__device__ __forceinline__ void unpack8(u32x4 v, float (&f)[8]) { f[0] = bf_lo(v.x); f[1] = bf_hi(v.x); f[2] = bf_lo(v.y); f[3] = bf_hi(v.y); f[4] = bf_lo(v.z); f[5] = bf_hi(v.z); f[6] = bf_lo(v.w); f[7] = bf_hi(v.w); }
__device__ __forceinline__ float wave_sum(float v) {
#pragma unroll
    for (int o = 32; o >= 1; o >>= 1) v += __shfl_xor(v, o);
    return v;
}
__device__ __forceinline__ int ltid() { int t = threadIdx.x; asm volatile("" : "+v"(t)); return t; }
__device__ __forceinline__ int chunk_row0(int b, int c) { return c < 2 ? TL + b * CTXL + c * 128 : b * SEQ + (c - 2) * 128; }

__device__ __forceinline__ void phase_adaln(const Args& a, LAS unsigned char* lds) {
    LAS float* sv = (LAS float*)lds;
    LAS float* red = (LAS float*)(lds + 36864);
    float* mod = (float*)(a.ws + WS_MOD);
    const int tid = ltid(), lane = tid & 63, wave = __builtin_amdgcn_readfirstlane(tid >> 6);
    for (int i = tid; i < 9 * 1024; i += 512) { const int r = i >> 10, k = i & 1023; const float v = r < 8 ? a.c[r * 1024 + k] : a.c_ctx[k]; sv[i] = silu_f(v); }
    __syncthreads();
    for (int unit = blockIdx.x; unit < 4 * 48; unit += gridDim.x) {
        const int l = unit / 48, cb = (unit % 48) * 64;
        const float* w = a.w_ada + (size_t)l * 1024 * 3072 + cb + lane;
        float acc[9];
#pragma unroll
        for (int r = 0; r < 9; ++r) acc[r] = 0.f;
#pragma unroll 4
        for (int kk = 0; kk < 128; ++kk) {
            const int k = wave * 128 + kk; const float wv = w[(size_t)k * 3072];
#pragma unroll
            for (int r = 0; r < 9; ++r) acc[r] += sv[r * 1024 + k] * wv;
        }
#pragma unroll
        for (int r = 0; r < 9; ++r) red[(wave * 9 + r) * 64 + lane] = acc[r];
        __syncthreads();
        for (int i = tid; i < 9 * 64; i += 512) {
            const int r = i >> 6, cl = i & 63; float s = 0.f;
#pragma unroll
            for (int w8 = 0; w8 < 8; ++w8) s += red[(w8 * 9 + r) * 64 + cl];
            mod[(l * 9 + r) * 3072 + cb + cl] = s + a.b_ada[l * 3072 + cb + cl];
        }
        __syncthreads();
    }
}

__device__ __forceinline__ void convert_wT(const float* src, int ld, int ncols, bf16_t* dst, LAS unsigned char* lds) {
    LAS bf16_t* tile = (LAS bf16_t*)lds;
    const int tid = ltid();
    const int ntiles = 16 * (ncols / 64);
    for (int ti = blockIdx.x; ti < ntiles; ti += gridDim.x) {
        const int k0 = (ti & 15) * 64, n0 = (ti >> 4) * 64;
        const int r = tid >> 4, c4 = (tid & 15) * 4;
#pragma unroll
        for (int i = 0; i < 2; ++i) {
            const int k = r + 32 * i;
            const float4 v = *(const float4*)(src + (size_t)(k0 + k) * ld + n0 + c4);
            tile[(c4 + 0) * 72 + k] = f2bf(v.x); tile[(c4 + 1) * 72 + k] = f2bf(v.y); tile[(c4 + 2) * 72 + k] = f2bf(v.z); tile[(c4 + 3) * 72 + k] = f2bf(v.w);
        }
        __syncthreads();
        const int n = tid >> 3, ks = (tid & 7) * 8;
        const u32x4 v = *(LAS u32x4*)(tile + n * 72 + ks);
        *(u32x4*)(dst + (size_t)(n0 + n) * 1024 + k0 + ks) = v;
        __syncthreads();
    }
}
__device__ __forceinline__ void convert_win_queued(const Args& a, LAS unsigned char* lds, int layer_next, unsigned* ctr) {
    LAS bf16_t* tile = (LAS bf16_t*)lds;
    LAS volatile int* qslot = (LAS volatile int*)(lds + LDS_BYTES - 64);
    const int tid = ltid();
    const float* src = a.w_in + (size_t)layer_next * 1024 * INW; bf16_t* dst = (bf16_t*)(a.ws + WS_WIN);
#pragma unroll 1
    for (;;) {
        __syncthreads();
        if (tid == 0) *qslot = (int)__hip_atomic_fetch_add(ctr, 1u, __ATOMIC_RELAXED, __HIP_MEMORY_SCOPE_AGENT);
        __syncthreads();
        const int ti = __builtin_amdgcn_readfirstlane(*qslot);
        if (ti >= 16 * 64) break;
        const int k0 = (ti & 15) * 64, n0 = (ti >> 4) * 64;
        const int r = tid >> 4, c4 = (tid & 15) * 4;
#pragma unroll
        for (int i = 0; i < 2; ++i) {
            const int k = r + 32 * i;
            const float4 v = *(const float4*)(src + (size_t)(k0 + k) * INW + n0 + c4);
            tile[(c4 + 0) * 72 + k] = f2bf(v.x); tile[(c4 + 1) * 72 + k] = f2bf(v.y); tile[(c4 + 2) * 72 + k] = f2bf(v.z); tile[(c4 + 3) * 72 + k] = f2bf(v.w);
        }
        __syncthreads();
        const int n = tid >> 3, ks = (tid & 7) * 8;
        *(u32x4*)(dst + (size_t)(n0 + n) * 1024 + k0 + ks) = *(LAS u32x4*)(tile + n * 72 + ks);
    }
}
__device__ __forceinline__ void convert_layer_weights(const Args& a, LAS unsigned char* lds, int layer) {
    convert_wT(a.w_in + (size_t)layer * 1024 * INW, INW, 4096, (bf16_t*)(a.ws + WS_WIN), lds);
    convert_wT(a.w_out + (size_t)layer * 1024 * 1024, 1024, 1024, (bf16_t*)(a.ws + WS_WOUT), lds);
}

__device__ __forceinline__ float4 ntload4(const float* p) { const f32x4 v = __builtin_nontemporal_load((const f32x4*)p); return make_float4(v[0], v[1], v[2], v[3]); }
__device__ __forceinline__ void ntstore4(float* p, const float4& v) { const f32x4 w = {v.x, v.y, v.z, v.w}; __builtin_nontemporal_store(w, (f32x4*)p); }
struct RowCtx {
    const Args* a; LAS float* wdt; LAS float* gpl; LAS float* gnl; LAS float* gateL; LAS float* shiftL; LAS float* scaleL;
    float* xctx; bf16_t* hb; float* dtr; const bf16_t* outp; const float* xlat; const float* xcx; int lpost, lnorm, lane;
};
__device__ __forceinline__ void rows_load(const RowCtx& c, int row, float4 (&xv)[4], u32x2 (&ov)[4]) {
    const float* xsrc = row < TL ? c.xlat + (size_t)row * 1024 : c.xcx + (size_t)(row - TL) * 1024;
#pragma unroll
    for (int j = 0; j < 4; ++j) { xv[j] = ntload4(xsrc + j * 256 + c.lane * 4); ov[j] = (c.lpost >= 0) ? __builtin_nontemporal_load((const u32x2*)(c.outp + (size_t)row * 1024 + j * 256 + c.lane * 4)) : (u32x2){0u, 0u}; }
}
__device__ __forceinline__ void rows_compute(const RowCtx& c, int row, float4 (&xv)[4], const u32x2 (&ov)[4]) {
    const Args& a = *c.a; const int lpost = c.lpost, lnorm = c.lnorm, lane = c.lane;
    LAS float* wdt = c.wdt; LAS float* gpl = c.gpl; LAS float* gnl = c.gnl; LAS float* gateL = c.gateL; LAS float* shiftL = c.shiftL; LAS float* scaleL = c.scaleL;
    float* xctx = c.xctx; bf16_t* hb = c.hb; float* dtr = c.dtr;
        const bool isctx = row >= TL; const int mb = isctx ? 8 : (row >> 12);
        float* xdst = isctx ? xctx + (size_t)(row - TL) * 1024 : a.out + (size_t)row * 1024;
        if (lpost >= 0) {
            float of[4][4]; float ss = 0.f;
#pragma unroll
            for (int j = 0; j < 4; ++j) { of[j][0] = bf_lo(ov[j].x); of[j][1] = bf_hi(ov[j].x); of[j][2] = bf_lo(ov[j].y); of[j][3] = bf_hi(ov[j].y); ss += of[j][0] * of[j][0] + of[j][1] * of[j][1] + of[j][2] * of[j][2] + of[j][3] * of[j][3]; }
            ss = wave_sum(ss); const float rinv = rsqrtf(ss * (1.f / 1024.f) + EPSN);
            LAS const float* gate = gateL + mb * 1024;
#pragma unroll
            for (int j = 0; j < 4; ++j) {
                const int e = j * 256 + lane * 4; const f32x4 g4 = *(LAS const f32x4*)(gpl + e), t4 = *(LAS const f32x4*)(gate + e);
                xv[j].x += t4[0] * (of[j][0] * rinv * g4[0]); xv[j].y += t4[1] * (of[j][1] * rinv * g4[1]); xv[j].z += t4[2] * (of[j][2] * rinv * g4[2]); xv[j].w += t4[3] * (of[j][3] * rinv * g4[3]);
                ntstore4(xdst + e, xv[j]);
            }
        }
        if (lnorm >= 0) {
            float ss = 0.f;
#pragma unroll
            for (int j = 0; j < 4; ++j) ss += xv[j].x * xv[j].x + xv[j].y * xv[j].y + xv[j].z * xv[j].z + xv[j].w * xv[j].w;
            ss = wave_sum(ss); const float rinv = rsqrtf(ss * (1.f / 1024.f) + EPSN);
            LAS const float* shift = shiftL + mb * 1024; LAS const float* scale = scaleL + mb * 1024;
            float acc[8];
#pragma unroll
            for (int i = 0; i < 8; ++i) acc[i] = 0.f;
#pragma unroll
            for (int j = 0; j < 4; ++j) {
                const int e = j * 256 + lane * 4; const f32x4 g4 = *(LAS const f32x4*)(gnl + e), s4 = *(LAS const f32x4*)(scale + e), h4 = *(LAS const f32x4*)(shift + e);
                float hv[4];
                hv[0] = xv[j].x * rinv * g4[0] * (1.f + s4[0]) + h4[0]; hv[1] = xv[j].y * rinv * g4[1] * (1.f + s4[1]) + h4[1];
                hv[2] = xv[j].z * rinv * g4[2] * (1.f + s4[2]) + h4[2]; hv[3] = xv[j].w * rinv * g4[3] * (1.f + s4[3]) + h4[3];
                u32x2 pk; pk.x = pk2(hv[0], hv[1]); pk.y = pk2(hv[2], hv[3]);
                *(u32x2*)(hb + (size_t)row * 1024 + e) = pk;
#pragma unroll
                for (int i = 0; i < 8; ++i) { const f32x4 w = *(LAS f32x4*)(wdt + i * 1024 + e); acc[i] += hv[0] * w[0] + hv[1] * w[1] + hv[2] * w[2] + hv[3] * w[3]; }
            }
            {
                const bool b5 = lane & 32, b4 = lane & 16, b3 = lane & 8;
                float t4[4], t2[2];
#pragma unroll
                for (int i = 0; i < 4; ++i) { const float keep = b5 ? acc[i + 4] : acc[i], send = b5 ? acc[i] : acc[i + 4]; t4[i] = keep + __shfl_xor(send, 32); }
#pragma unroll
                for (int i = 0; i < 2; ++i) { const float keep = b4 ? t4[i + 2] : t4[i], send = b4 ? t4[i] : t4[i + 2]; t2[i] = keep + __shfl_xor(send, 16); }
                float v = (b3 ? t2[1] : t2[0]) + __shfl_xor(b3 ? t2[0] : t2[1], 8);
                v += __shfl_xor(v, 4); v += __shfl_xor(v, 2); v += __shfl_xor(v, 1);
                if ((lane & 7) == 0) dtr[(size_t)row * 8 + ((lane >> 5) & 1) * 4 + ((lane >> 4) & 1) * 2 + ((lane >> 3) & 1)] = v;
            }
        }
}
__device__ __forceinline__ void phase_rows(const Args& a, LAS unsigned char* lds, int lpost, int lnorm) {
    LAS float* wdt = (LAS float*)lds;
    const int tid = ltid(), lane = tid & 63, wave = __builtin_amdgcn_readfirstlane(tid >> 6);
    const float* mod = (const float*)(a.ws + WS_MOD);
    const bf16_t* outp = (const bf16_t*)(a.ws + WS_U);
    float* xctx = (float*)(a.ws + WS_XCTX);
    bf16_t* hb = (bf16_t*)(a.ws + WS_H);
    float* dtr = (float*)(a.ws + WS_DTR);
    if (lnorm >= 0) for (int i = tid; i < 8192; i += 512) wdt[(i & 7) * 1024 + (i >> 3)] = a.w_in[((size_t)lnorm * 1024 + (i >> 3)) * INW + 4096 + (i & 7)];
    LAS float* gpl = (LAS float*)(lds + 32768); LAS float* gnl = gpl + 1024; LAS float* gateL = gnl + 1024; LAS float* shiftL = gateL + 9 * 1024; LAS float* scaleL = shiftL + 9 * 1024;
    for (int i = tid; i < 1024; i += 512) { gpl[i] = lpost >= 0 ? a.g_post[lpost * 1024 + i] : 0.f; gnl[i] = lnorm >= 0 ? a.g_pre[lnorm * 1024 + i] : 0.f; }
    for (int i = tid; i < 9 * 1024; i += 512) {
        const int r = i >> 10, e = i & 1023;
        gateL[i] = lpost >= 0 ? mod[(lpost * 9 + r) * 3072 + 2048 + e] : 0.f;
        shiftL[i] = lnorm >= 0 ? mod[(lnorm * 9 + r) * 3072 + e] : 0.f; scaleL[i] = lnorm >= 0 ? mod[(lnorm * 9 + r) * 3072 + 1024 + e] : 0.f;
    }
    __syncthreads();
    RowCtx c; c.a = &a; c.wdt = wdt; c.gpl = gpl; c.gnl = gnl; c.gateL = gateL; c.shiftL = shiftL; c.scaleL = scaleL; c.xctx = xctx; c.hb = hb; c.dtr = dtr; c.outp = outp;
    c.xlat = lpost <= 0 ? a.x : (const float*)a.out; c.xcx = lpost <= 0 ? a.ctx : (const float*)xctx; c.lpost = lpost; c.lnorm = lnorm; c.lane = lane;
    const int rs = gridDim.x * 8, row0 = blockIdx.x * 8 + wave;
    const int rend = (lpost == DEPTH - 1) ? TL : TT;
    float4 xa[4], xb[4], xc[4]; u32x2 oa[4], ob[4], oc[4];
#define ROW_OK(r) ((r) < rend ? (r) : row0)
    if (row0 < rend) {
        rows_load(c, row0, xa, oa); rows_load(c, ROW_OK(row0 + rs), xb, ob);
#pragma unroll 1
        for (int row = row0; row < rend; row += 3 * rs) {
            rows_load(c, ROW_OK(row + 2 * rs), xc, oc); rows_compute(c, row, xa, oa);
            if (row + rs < rend) { rows_load(c, ROW_OK(row + 3 * rs), xa, oa); rows_compute(c, row + rs, xb, ob); }
            if (row + 2 * rs < rend) { rows_load(c, ROW_OK(row + 4 * rs), xb, ob); rows_compute(c, row + 2 * rs, xc, oc); }
        }
    }
#undef ROW_OK
}

__device__ __forceinline__ void seq_nb(int t, bool& hasp, bool& hasn) {
    int pos, len; if (t < TL) { pos = t & (SEQ - 1); len = SEQ; } else { pos = (t - TL) & (CTXL - 1); len = CTXL; }
    hasp = pos > 0; hasn = pos < len - 1;
}
__device__ __forceinline__ void ssd_conv8(const bf16_t* __restrict__ u, const float* __restrict__ cw, const float* __restrict__ cb, int t, int ch0, bool hasp, bool hasn, float (&o)[8]) {
    const bf16_t* p = u + (size_t)t * ULD + U_XBC + ch0;
    float v0[8], v1[8], v2[8];
    const u32x4 z = {0u, 0u, 0u, 0u};
    unpack8(hasp ? *(const u32x4*)(p - ULD) : z, v0); unpack8(*(const u32x4*)p, v1); unpack8(hasn ? *(const u32x4*)(p + ULD) : z, v2);
#pragma unroll
    for (int i = 0; i < 8; ++i) { const float s = cw[ch0 + i] * v0[i] + cw[768 + ch0 + i] * v1[i] + cw[1536 + ch0 + i] * v2[i] + cb[ch0 + i]; o[i] = silu_f(s); }
}
__device__ __forceinline__ void phase_prep(const Args& a, LAS unsigned char* lds, int layer) {
    typedef float f32x2 __attribute__((ext_vector_type(2)));
    LAS f32x2* tab = (LAS f32x2*)lds;
    const int tid = ltid();
    const bf16_t* __restrict__ u = (const bf16_t*)(a.ws + WS_U);
    bf16_t* __restrict__ ymix = (bf16_t*)(a.ws + WS_H);
    bf16_t* __restrict__ xbc = (bf16_t*)(a.ws + WS_XBC);
    for (int i = tid; i < 2048; i += 512) {
        const int pos = i >> 5, f = i & 31;
        const float inv = exp2f(-(float)f * 0.41524101186092029f);
        const float ang = (float)pos * inv;
        const float n = rintf(ang * 0.15915494309189535f);
        float rr = fmaf(-n, 6.28125f, ang); rr = fmaf(-n, 0.0019353071795864769f, rr);
        f32x2 cs; cs.x = __cosf(rr); cs.y = __sinf(rr); tab[i] = cs;
    }
    __syncthreads();
    const int gstride = gridDim.x * 512, g0 = blockIdx.x * 512 + tid;
    const float* caw = a.conv_a_w + layer * 768;
#pragma unroll 2
    for (int it = g0; it < TT * 32; it += gstride) {
        const int t = it >> 5, ch0 = (it & 31) * 8; bool hasp, hasn; seq_nb(t, hasp, hasn);
        const bf16_t* p = u + (size_t)t * ULD + ch0; const u32x4 z = {0u, 0u, 0u, 0u};
        float i0[8], i1[8], i2[8], c0[8], c1[8], c2[8], bb[8], zz[8], o[8];
        unpack8(hasp ? *(const u32x4*)(p + U_SCIN - ULD) : z, i0); unpack8(*(const u32x4*)(p + U_SCIN), i1); unpack8(hasn ? *(const u32x4*)(p + U_SCIN + ULD) : z, i2);
        unpack8(hasp ? *(const u32x4*)(p + U_SCC - ULD) : z, c0); unpack8(*(const u32x4*)(p + U_SCC), c1); unpack8(hasn ? *(const u32x4*)(p + U_SCC + ULD) : z, c2);
        unpack8(*(const u32x4*)(p + U_SCB), bb); unpack8(*(const u32x4*)(p + U_SCZ), zz);
#pragma unroll
        for (int i = 0; i < 8; ++i) {
            const float cv = caw[ch0 + i] * (c0[i] * i0[i]) + caw[256 + ch0 + i] * (c1[i] * i1[i]) + caw[512 + ch0 + i] * (c2[i] * i2[i]);
            o[i] = bb[i] * cv * silu_f(zz[i]);
        }
        *(u32x4*)(ymix + (size_t)t * 1024 + ch0) = __builtin_bit_cast(u32x4, pack8(o));
    }
    const float* cw = a.ssd_conv_w + layer * 3 * 768; const float* cb = a.ssd_conv_b + layer * 768;
#pragma unroll 4
    for (int it = g0; it < TT * 32; it += gstride) {
        const int t = it >> 5, ch0 = (it & 31) * 8; bool hasp, hasn; seq_nb(t, hasp, hasn);
        float o[8]; ssd_conv8(u, cw, cb, t, ch0, hasp, hasn, o);
        *(u32x4*)(xbc + (size_t)t * 768 + ch0) = __builtin_bit_cast(u32x4, pack8(o));
    }
#pragma unroll 2
    for (int it = g0; it < TT * 32; it += gstride) {
        const int t = it >> 5, ru = it & 31, blk = ru >> 2, sub = ru & 3; bool hasp, hasn; seq_nb(t, hasp, hasn);
        const int chA = 256 + blk * 64 + sub * 8, chB = chA + 32;
        float t1[8], t2[8]; ssd_conv8(u, cw, cb, t, chA, hasp, hasn, t1); ssd_conv8(u, cw, cb, t, chB, hasp, hasn, t2);
        if (t < TL) {
            const int l = t & (SEQ - 1); const int pos = (blk & 1) ? (l & 63) : (l >> 6);
#pragma unroll
            for (int i = 0; i < 8; ++i) { const f32x2 cs = tab[pos * 32 + sub * 8 + i]; const float x1 = t1[i], x2 = t2[i]; t1[i] = x1 * cs.x - x2 * cs.y; t2[i] = x1 * cs.y + x2 * cs.x; }
        }
        *(u32x4*)(xbc + (size_t)t * 768 + chA) = __builtin_bit_cast(u32x4, pack8(t1));
        *(u32x4*)(xbc + (size_t)t * 768 + chB) = __builtin_bit_cast(u32x4, pack8(t2));
    }
    {
        LAS bf16_t* tile = (LAS bf16_t*)(lds + 16384);
        bf16_t* vt = (bf16_t*)(a.ws + WS_VT);
#define VT_SRC(TI, ROW0, HH) do { if ((TI) < 4096) { ROW0 = ((TI) >> 9) * SEQ + ((TI) & 63) * 64; HH = ((TI) >> 6) & 7; } else { const int tj_ = (TI) - 4096; ROW0 = TL + (tj_ >> 5) * CTXL + (tj_ & 3) * 64; HH = (tj_ >> 2) & 7; } } while (0)
        const int tok = tid >> 3, seg = tid & 7;
        int ti = blockIdx.x;
        u32x4 v = {0u, 0u, 0u, 0u};
        if (ti < 4096 + 256) { int r0_, h_; VT_SRC(ti, r0_, h_); v = *(const u32x4*)(u + (size_t)(r0_ + tok) * ULD + U_V + h_ * 64 + seg * 8); }
        for (; ti < 4096 + 256; ti += gridDim.x) {
            const int tn = ti + (int)gridDim.x < 4096 + 256 ? ti + (int)gridDim.x : ti;
            int rn_, hn_; VT_SRC(tn, rn_, hn_);
            const u32x4 vn = *(const u32x4*)(u + (size_t)(rn_ + tok) * ULD + U_V + hn_ * 64 + seg * 8);
            int b, h; size_t obase; const int ostride = 32;
            if (ti < 4096) { b = ti >> 9; h = (ti >> 6) & 7; const int tb = ti & 63; obase = (size_t)(b * 8 + h) * 64 * VLD + (size_t)tb * 4096; }
            else { const int tj = ti - 4096; b = tj >> 5; h = (tj >> 2) & 7; const int tb = tj & 3; obase = VT_CTX + (size_t)(b * 8 + h) * 64 * CTXL + (size_t)tb * 4096; }
            tile[(seg * 8 + 0) * 72 + tok] = (bf16_t)(v.x & 0xffffu); tile[(seg * 8 + 1) * 72 + tok] = (bf16_t)(v.x >> 16);
            tile[(seg * 8 + 2) * 72 + tok] = (bf16_t)(v.y & 0xffffu); tile[(seg * 8 + 3) * 72 + tok] = (bf16_t)(v.y >> 16);
            tile[(seg * 8 + 4) * 72 + tok] = (bf16_t)(v.z & 0xffffu); tile[(seg * 8 + 5) * 72 + tok] = (bf16_t)(v.z >> 16);
            tile[(seg * 8 + 6) * 72 + tok] = (bf16_t)(v.w & 0xffffu); tile[(seg * 8 + 7) * 72 + tok] = (bf16_t)(v.w >> 16);
            __syncthreads();
            const int d = tid >> 3, ts = (tid & 7) * 8;
            *(u32x4*)(vt + obase + (size_t)(ts >> 5) * 2048 + (size_t)d * ostride + (ts & 31)) = *(LAS u32x4*)(tile + d * 72 + ts);
            __syncthreads();
            v = vn;
        }
#undef VT_SRC
    }
    const float* dtr = (const float*)(a.ws + WS_DTR); float* dts = (float*)(a.ws + WS_DTS);
    for (int it = g0; it < TT * 8; it += gstride) {
        const int j = it & 7; const float bias = j < 4 ? a.dt_bias_f[layer * 4 + j] : a.dt_bias_b[layer * 4 + j - 4];
        dts[it] = softplus_f(dtr[it] + bias);
    }
}

__device__ __forceinline__ void phase_s1(const Args& a, LAS unsigned char* lds, int layer) {
    LAS bf16_t* xs = (LAS bf16_t*)lds;
    LAS bf16_t* bs = xs + 128 * XS_LD;
    LAS float* wl = (LAS float*)(lds + 2 * 128 * XS_LD * 2);
    const int tid = ltid(), lane = tid & 63, wave = __builtin_amdgcn_readfirstlane(tid >> 6), r16 = lane & 15, quad = lane >> 4;
    const bf16_t* xbc = (const bf16_t*)(a.ws + WS_XBC);
    const float* dts = (const float*)(a.ws + WS_DTS); float* acs = (float*)(a.ws + WS_ACS); float* cdec = (float*)(a.ws + WS_CDEC); bf16_t* st = (bf16_t*)(a.ws + WS_ST);
    const int h = wave >> 1, dir = wave & 1, g = h >> 1;
    const float a_h = -__expf(dir ? a.a_log_b[layer * 4 + h] : a.a_log_f[layer * 4 + h]);
    for (int unit = blockIdx.x; unit < NB * NCH; unit += gridDim.x) {
        const int b = unit / NCH, c = unit % NCH, row0 = chunk_row0(b, c);
        {
            const int i0 = dir ? 127 - 2 * lane : 2 * lane, i1 = dir ? 126 - 2 * lane : 2 * lane + 1;
            const float d0 = dts[(size_t)(row0 + i0) * 8 + dir * 4 + h], d1 = dts[(size_t)(row0 + i1) * 8 + dir * 4 + h];
            const float v0 = d0 * a_h, v1 = d1 * a_h, tot = v0 + v1; float incl = tot;
#pragma unroll
            for (int o = 1; o < 64; o <<= 1) { const float tv = __shfl_up(incl, o); if (lane >= o) incl += tv; }
            const float excl = incl - tot, c0 = excl + v0, c1 = excl + tot, total = __shfl(incl, 63);
            acs[(size_t)(row0 + i0) * 8 + dir * 4 + h] = c0; acs[(size_t)(row0 + i1) * 8 + dir * 4 + h] = c1;
            wl[wave * 128 + i0] = __expf(total - c0) * d0; wl[wave * 128 + i1] = __expf(total - c1) * d1;
            if (lane == 0) cdec[((b * NCH + c) * 4 + h) * 2 + dir] = __expf(total);
        }
        for (int i = tid; i < 8192; i += 512) {
            const int j = i >> 6, seg = i & 63; const u32x4 v = *(const u32x4*)(xbc + (size_t)(row0 + j) * 768 + seg * 8);
            if (seg < 32) *(LAS u32x4*)(xs + j * XS_LD + seg * 8) = v; else *(LAS u32x4*)(bs + j * XS_LD + (seg - 32) * 8) = v;
        }
        __syncthreads();
        bf16x8 A[4][4];
#pragma unroll
        for (int pt = 0; pt < 4; ++pt)
#pragma unroll
            for (int js = 0; js < 4; ++js) {
                const int trow = js * 32 + quad * 8 + (r16 >> 2), tcol = h * 64 + pt * 16 + (r16 & 3) * 4;
                const s16x4 x0 = __builtin_amdgcn_ds_read_tr16_b64_v4i16((LAS s16x4*)(xs + trow * XS_LD + tcol));
                const s16x4 x1 = __builtin_amdgcn_ds_read_tr16_b64_v4i16((LAS s16x4*)(xs + (trow + 4) * XS_LD + tcol));
                const f32x4 w0 = *(LAS const f32x4*)(wl + wave * 128 + js * 32 + quad * 8), w1 = *(LAS const f32x4*)(wl + wave * 128 + js * 32 + quad * 8 + 4);
                float f[8];
#pragma unroll
                for (int e = 0; e < 4; ++e) { f[e] = bf2f((bf16_t)x0[e]) * w0[e]; f[4 + e] = bf2f((bf16_t)x1[e]) * w1[e]; }
                A[pt][js] = pack8(f);
            }
        bf16_t* stp = st + (size_t)(((b * NCH + c) * 4 + h) * 2 + dir) * 8192;
#pragma unroll 1
        for (int nt = 0; nt < 8; ++nt) {
            f32x4 acc[4];
#pragma unroll
            for (int pt = 0; pt < 4; ++pt) acc[pt] = (f32x4){0.f, 0.f, 0.f, 0.f};
#pragma unroll
            for (int js = 0; js < 4; ++js) {
                const int trow = js * 32 + quad * 8 + (r16 >> 2), tcol = g * 128 + nt * 16 + (r16 & 3) * 4;
                const s16x4 b0 = __builtin_amdgcn_ds_read_tr16_b64_v4i16((LAS s16x4*)(bs + trow * XS_LD + tcol));
                const s16x4 b1 = __builtin_amdgcn_ds_read_tr16_b64_v4i16((LAS s16x4*)(bs + (trow + 4) * XS_LD + tcol));
                const bf16x8 bv = __builtin_shufflevector(b0, b1, 0, 1, 2, 3, 4, 5, 6, 7);
#pragma unroll
                for (int pt = 0; pt < 4; ++pt) acc[pt] = mfma16(bv, A[pt][js], acc[pt]);
            }
#pragma unroll
            for (int pt = 0; pt < 4; ++pt) { u32x2 w; w.x = pk2(acc[pt][0], acc[pt][1]); w.y = pk2(acc[pt][2], acc[pt][3]); *(u32x2*)(stp + (pt * 16 + r16) * 128 + nt * 16 + quad * 4) = w; }
        }
        __syncthreads();
    }
}

__device__ __forceinline__ void phase_scan(const Args& a) {
    bf16_t* st = (bf16_t*)(a.ws + WS_ST); const float* cdec = (const float*)(a.ws + WS_CDEC);
    const int tid_ = ltid();
    for (int it = blockIdx.x * 512 + tid_; it < 64 * 2048; it += gridDim.x * 512) {
        const int bhd = it >> 11, e4 = it & 2047, b = bhd >> 3, h = (bhd >> 1) & 3, dir = bhd & 1;
        float s0 = 0.f, s1 = 0.f, s2 = 0.f, s3 = 0.f;
        int sidx = ((b * NCH + (dir ? 1 : 0)) * 4 + h) * 2 + dir;
        u32x2 vn = *(const u32x2*)(st + (size_t)sidx * 8192 + e4 * 4); float dn = cdec[sidx];
#pragma unroll 2
        for (int step = 0; step < NCH; ++step) {
            u32x2* p = (u32x2*)(st + (size_t)sidx * 8192 + e4 * 4);
            const u32x2 v = vn; const float dec = dn;
            if (step + 1 < NCH) {
                const int c2 = dir ? (step + 1 < 2 ? 1 - (step + 1) : 35 - (step + 1)) : step + 1;
                sidx = ((b * NCH + c2) * 4 + h) * 2 + dir;
                vn = *(const u32x2*)(st + (size_t)sidx * 8192 + e4 * 4); dn = cdec[sidx];
            }
            u32x2 o; o.x = pk2(s0, s1); o.y = pk2(s2, s3); *p = o;
            s0 = s0 * dec + bf_lo(v.x); s1 = s1 * dec + bf_hi(v.x); s2 = s2 * dec + bf_lo(v.y); s3 = s3 * dec + bf_hi(v.y);
        }
    }
}

struct KVFrag { bf16x8 k[4]; bf16x8 v[4]; };
__device__ __forceinline__ void kv_load(KVFrag& f, const bf16_t* kp, const bf16_t* vp, int vstride16) {
    f.k[0] = ldg8(kp); f.k[1] = ldg8(kp + 512); f.k[2] = ldg8(kp + 1024); f.k[3] = ldg8(kp + 1536);
#pragma unroll
    for (int db = 0; db < 4; ++db) f.v[db] = ldg8(vp + (size_t)db * vstride16);
}
__device__ __forceinline__ void attn_block(const KVFrag& f, LAS const bf16_t* ql, float (&m)[2], float (&l)[2], f32x4 (&O)[2][4], LAS const float* rprow, bool isw, int half32, const int (&cib0)[2], const int (&d0)[2]) {
#pragma unroll
    for (int jl = 0; jl < 2; ++jl) {
        f32x4 s0 = {0.f, 0.f, 0.f, 0.f}, s1 = {0.f, 0.f, 0.f, 0.f};
        LAS const bf16_t* qv = ql + jl * 16 * 72; asm volatile("" : "+v"(qv));
        const bf16x8 q0 = *(LAS const bf16x8*)qv, q1 = *(LAS const bf16x8*)(qv + 32);
        s0 = mfma16(f.k[0], q0, s0); s0 = mfma16(f.k[1], q1, s0);
        s1 = mfma16(f.k[2], q0, s1); s1 = mfma16(f.k[3], q1, s1);
        float sv[8];
        if (isw) {
            LAS const float* bp = rprow + (cib0[jl] + half32); const int d = d0[jl] + half32;
#pragma unroll
            for (int e = 0; e < 8; ++e) sv[e] = bp[e];
#pragma unroll
            for (int e = 0; e < 8; ++e) { const float sc = (e < 4 ? s0[e & 3] : s1[e & 3]); const float t = fmaf(sc, 0.18033688011112042f, sv[e]); sv[e] = ((unsigned)(d + e) < 16u) ? t : -1e30f; }
        } else {
#pragma unroll
            for (int e = 0; e < 4; ++e) { sv[e] = s0[e] * 0.18033688011112042f; sv[4 + e] = s1[e] * 0.18033688011112042f; }
        }
        float bm = fmaxf(fmaxf(fmaxf(sv[0], sv[1]), fmaxf(sv[2], sv[3])), fmaxf(fmaxf(sv[4], sv[5]), fmaxf(sv[6], sv[7])));
        bm = fmaxf(bm, __shfl_xor(bm, 16)); bm = fmaxf(bm, __shfl_xor(bm, 32));
        if (__builtin_amdgcn_ballot_w64(bm > m[jl]) != 0ull) {
            const float mn = fmaxf(m[jl], bm), alpha = __builtin_amdgcn_exp2f(m[jl] - mn);
            m[jl] = mn; l[jl] *= alpha;
#pragma unroll
            for (int db = 0; db < 4; ++db) O[jl][db] *= alpha;
        }
        const float mc = m[jl];
        float ps = 0.f;
#pragma unroll
        for (int e = 0; e < 8; ++e) { sv[e] = __builtin_amdgcn_exp2f(sv[e] - mc); ps += sv[e]; }
        l[jl] += ps;
        const bf16x8 pb = pack8(sv);
#pragma unroll
        for (int db = 0; db < 4; ++db) O[jl][db] = mfma16(f.v[db], pb, O[jl][db]);
    }
}
template <bool WIN>
__device__ __forceinline__ void attn_row(const Args& a, int b, int r, int jp, int h, int lane, LAS const float* rpl, LAS bf16_t* qls) {
    const bf16_t* u = (const bf16_t*)(a.ws + WS_U); bf16_t* ymix = (bf16_t*)(a.ws + WS_H); const bf16_t* vt = (const bf16_t*)(a.ws + WS_VT);
    const int r16 = lane & 15, quad = lane >> 4;
    const int qrow0 = WIN ? b * SEQ + r * 64 + jp * 32 : TL + b * CTXL + r * 32;
    const int r0 = WIN ? min(max(r - 4, 0), 56) : 0;
#pragma unroll
    for (int t = 0; t < 4; ++t) { const int i = lane + 64 * t, row = i >> 3, seg = i & 7; *(LAS bf16x8*)(qls + row * 72 + seg * 8) = ldg8(u + (size_t)(qrow0 + row) * ULD + U_Q + h * 64 + seg * 8); }
    LAS const bf16_t* ql = qls + r16 * 72 + quad * 8;
    float m[2], l[2]; f32x4 O[2][4];
#pragma unroll
    for (int jl = 0; jl < 2; ++jl) { m[jl] = -1e30f; l[jl] = 0.f;
#pragma unroll
        for (int db = 0; db < 4; ++db) O[jl][db] = (f32x4){0.f, 0.f, 0.f, 0.f}; }
    const bf16_t* kbp = (const bf16_t*)(a.ws + WS_KB);
    const bf16_t* kctx = kbp + KB_CTX + (size_t)(b * 8 + h) * 8 * 2048 + r16 * 32 + quad * 8;
    const bf16_t* vctx = vt + VT_CTX + (size_t)(b * 8 + h) * 64 * CTXL + r16 * 32 + quad * 8;
    const bf16_t* kwin = kbp + ((size_t)(b * 8 + h) * 128 + r0 * 2) * 2048 + r16 * 32 + quad * 8;
    const bf16_t* vwin = vt + (size_t)(b * 8 + h) * 64 * VLD + (size_t)(r0 * 2) * 2048 + r16 * 32 + quad * 8;
    constexpr int NPAIR = WIN ? 12 : 4;
    int cib0[2], d0[2];
#pragma unroll
    for (int jl = 0; jl < 2; ++jl) { const int cq = jp * 32 + jl * 16 + r16, c0 = min(max(cq - 8, 0), 48); cib0[jl] = quad * 8 - cq + 15; d0[jl] = quad * 8 - c0; }
    KVFrag fa, fb;
    kv_load(fa, kctx, vctx, 512); kv_load(fb, kctx + 2048, vctx + 2048, 512);
#pragma unroll 1
    for (int pr = 0; pr < NPAIR; ++pr) {
        const int nx = pr + 1 < NPAIR ? pr + 1 : pr;
        const bool nctx = nx < 4;
        const bf16_t* nk = nctx ? kctx + (size_t)nx * 4096 : kwin + (size_t)(nx - 4) * 4096;
        const bf16_t* nv = nctx ? vctx + (size_t)nx * 4096 : vwin + (size_t)(nx - 4) * 4096;
        const int nstr = 512;
        const bool isw = WIN && pr >= 4;
        LAS const float* rprow = rpl + (isw ? (r0 + (pr - 4) - r + 7) : 15) * 32;
        attn_block(fa, ql, m, l, O, rprow, isw, 0, cib0, d0);
        kv_load(fa, nk, nv, nstr);
        attn_block(fb, ql, m, l, O, rprow, isw, 32, cib0, d0);
        kv_load(fb, nk + 2048, nv + 2048, nstr);
    }
#pragma unroll
    for (int jl = 0; jl < 2; ++jl) {
        float lt = l[jl]; lt += __shfl_xor(lt, 16); lt += __shfl_xor(lt, 32);
        const float inv = 1.f / lt;
        const size_t orow = (size_t)(qrow0 + jl * 16 + r16);
#pragma unroll
        for (int db = 0; db < 4; ++db) {
            const int ch = h * 64 + db * 16 + quad * 4;
            const u32x2 zz = *(const u32x2*)(u + orow * ULD + U_NAZ + ch);
            const float y0 = O[jl][db][0] * inv * silu_f(bf_lo(zz.x)), y1 = O[jl][db][1] * inv * silu_f(bf_hi(zz.x)), y2 = O[jl][db][2] * inv * silu_f(bf_lo(zz.y)), y3 = O[jl][db][3] * inv * silu_f(bf_hi(zz.y));
            u32x2 o; o.x = pk2(y0, y1); o.y = pk2(y2, y3);
            *(u32x2*)(ymix + orow * 1024 + 256 + ch) = o;
        }
    }
}
template <int G>
__device__ __forceinline__ void s3_group(const Args& a, int layer, LAS u32x2* Y, f32x4& ssv, LAS const bf16_t* xs, LAS const float* arr, const bf16_t* u, const bf16_t* xbc, const bf16_t* st,
                                         int b, int c, int row0, int wave, int r16, int quad) {
    const int iop = wave * 16 + r16;
    bf16x8 cf[4];
#pragma unroll
    for (int ks = 0; ks < 4; ++ks) cf[ks] = ldg8(xbc + (size_t)(row0 + iop) * 768 + 512 + G * 128 + ks * 32 + quad * 8);
    f32x4 accd[2][4];
#pragma unroll
    for (int hh = 0; hh < 2; ++hh)
#pragma unroll
        for (int pt = 0; pt < 4; ++pt) accd[hh][pt] = (f32x4){0.f, 0.f, 0.f, 0.f};
    LAS const float* dtf0 = arr + (0 * 4 + G * 2) * 128; LAS const float* dtb0 = arr + (1 * 4 + G * 2) * 128;
    LAS const float* af0 = arr + (2 * 4 + G * 2) * 128; LAS const float* ab0 = arr + (3 * 4 + G * 2) * 128;
#pragma unroll 1
    for (int jb = 0; jb < 4; ++jb) {
        f32x4 GT2[2];
#pragma unroll
        for (int t2 = 0; t2 < 2; ++t2) {
            f32x4 acc = {0.f, 0.f, 0.f, 0.f};
            const bf16_t* bp = xbc + (size_t)(row0 + (2 * jb + t2) * 16 + r16) * 768 + 256 + G * 128 + quad * 8;
#pragma unroll
            for (int ks = 0; ks < 4; ++ks) acc = mfma16(ldg8(bp + ks * 32), cf[ks], acc);
            GT2[t2] = acc;
        }
#pragma unroll
        for (int hh = 0; hh < 2; ++hh) {
            LAS const float* dtf = dtf0 + hh * 128; LAS const float* dtb = dtb0 + hh * 128; LAS const float* af = af0 + hh * 128; LAS const float* ab = ab0 + hh * 128;
            const float aif = af[iop], aib = ab[iop];
            float f[8];
#pragma unroll
            for (int s = 0; s < 8; ++s) {
                const int j = (2 * jb + (s >> 2)) * 16 + quad * 4 + (s & 3);
                const bool fw = j < iop;
                const float e = fw ? aif - af[j] : aib - ab[j];
                float m = (fw ? dtf[j] : dtb[j]) * __expf(fminf(e, 0.f));
                if (j == iop) m = dtf[j] + dtb[j];
                f[s] = GT2[s >> 2][s & 3] * m;
            }
            const bf16x8 aop = pack8(f);
#pragma unroll
            for (int pt = 0; pt < 4; ++pt) {
                const int trow = (2 * jb) * 16 + quad * 4 + (r16 >> 2), tcol = (G * 2 + hh) * 64 + pt * 16 + (r16 & 3) * 4;
                const s16x4 b0 = __builtin_amdgcn_ds_read_tr16_b64_v4i16((LAS s16x4*)(LAS bf16_t*)(xs + trow * XS_LD + tcol));
                const s16x4 b1 = __builtin_amdgcn_ds_read_tr16_b64_v4i16((LAS s16x4*)(LAS bf16_t*)(xs + (trow + 16) * XS_LD + tcol));
                const bf16x8 bop = __builtin_shufflevector(b0, b1, 0, 1, 2, 3, 4, 5, 6, 7);
                accd[hh][pt] = mfma16(aop, bop, accd[hh][pt]);
            }
            asm volatile("" ::: "memory");
        }
    }
#pragma unroll
    for (int hh = 0; hh < 2; ++hh) {
        const int h = G * 2 + hh;
#pragma unroll
        for (int dir = 0; dir < 2; ++dir) {
            const bf16_t* pp = st + (size_t)(((b * NCH + c) * 4 + h) * 2 + dir) * 8192;
            const float ei = __expf(arr[((2 + dir) * 4 + h) * 128 + iop]);
#pragma unroll
            for (int ks = 0; ks < 4; ++ks) {
                float cfv[8]; unpack8(__builtin_bit_cast(u32x4, cf[ks]), cfv);
#pragma unroll
                for (int s = 0; s < 8; ++s) cfv[s] *= ei;
                const bf16x8 aop = pack8(cfv);
#pragma unroll
                for (int pt = 0; pt < 4; ++pt) {
                    accd[hh][pt] = mfma16(aop, ldg8(pp + (pt * 16 + r16) * 128 + ks * 32 + quad * 8), accd[hh][pt]);
                }
            }
            asm volatile("" ::: "memory");
        }
        const float dh = a.ssd_d[layer * 4 + h];
#pragma unroll
        for (int pt = 0; pt < 4; ++pt) {
            f32x4 yv;
#pragma unroll
            for (int jj = 0; jj < 4; ++jj) {
                const int io = wave * 16 + quad * 4 + jj, ch = h * 64 + pt * 16 + r16;
                const float y = accd[hh][pt][jj] + dh * bf2f(xs[io * XS_LD + ch]);
                const float z = bf2f(u[(size_t)(row0 + io) * ULD + U_SSZ + ch]);
                yv[jj] = y * silu_f(z);
            }
            ssv += yv * yv;
            u32x2 pk; pk.x = pk2(yv[0], yv[1]); pk.y = pk2(yv[2], yv[3]);
            Y[(h * 4 + pt) * 64] = pk;
        }
    }
}
__device__ __forceinline__ void s3_unit(const Args& a, LAS unsigned char* lds, int layer, int b, int c) {
    LAS bf16_t* xs = (LAS bf16_t*)lds;
    LAS float* arr = (LAS float*)(lds + 128 * XS_LD * 2);
    const int tid = ltid(), lane = tid & 63, wave = __builtin_amdgcn_readfirstlane(tid >> 6), r16 = lane & 15, quad = lane >> 4;
    const bf16_t* u = (const bf16_t*)(a.ws + WS_U); bf16_t* ymix = (bf16_t*)(a.ws + WS_H);
    const bf16_t* xbc = (const bf16_t*)(a.ws + WS_XBC);
    const float* dts = (const float*)(a.ws + WS_DTS); const float* acs = (const float*)(a.ws + WS_ACS); const bf16_t* st = (const bf16_t*)(a.ws + WS_ST);
    {
        const int row0 = chunk_row0(b, c);
        for (int i = tid; i < 4096; i += 512) { const int j = i >> 5, seg = i & 31; *(LAS u32x4*)(xs + j * XS_LD + seg * 8) = *(const u32x4*)(xbc + (size_t)(row0 + j) * 768 + seg * 8); }
        for (int i = tid; i < 1024; i += 512) {
            const int j = i >> 3, col = i & 7;
            arr[((col < 4 ? 0 : 1) * 4 + (col & 3)) * 128 + j] = dts[(size_t)(row0 + j) * 8 + col];
            arr[((col < 4 ? 2 : 3) * 4 + (col & 3)) * 128 + j] = acs[(size_t)(row0 + j) * 8 + col];
        }
        __syncthreads();
        LAS u32x2* Y = (LAS u32x2*)(lds + 128 * XS_LD * 2 + 8192) + wave * 1024 + lane;
        f32x4 ssv = {0.f, 0.f, 0.f, 0.f};
        s3_group<0>(a, layer, Y, ssv, xs, arr, u, xbc, st, b, c, row0, wave, r16, quad);
        s3_group<1>(a, layer, Y, ssv, xs, arr, u, xbc, st, b, c, row0, wave, r16, quad);
        f32x4 rinv;
#pragma unroll
        for (int jj = 0; jj < 4; ++jj) {
            float ss = ssv[jj];
            ss += __shfl_xor(ss, 1); ss += __shfl_xor(ss, 2); ss += __shfl_xor(ss, 4); ss += __shfl_xor(ss, 8);
            rinv[jj] = rsqrtf(ss * (1.f / 256.f) + EPSN);
        }
        const float* nw = a.ssd_norm_w + layer * 256;
#pragma unroll
        for (int h = 0; h < 4; ++h)
#pragma unroll
            for (int pt = 0; pt < 4; ++pt) {
                const int ch = h * 64 + pt * 16 + r16; const float w = nw[ch]; const u32x2 yq = Y[(h * 4 + pt) * 64];
#pragma unroll
                for (int jj = 0; jj < 4; ++jj) {
                    const int io = wave * 16 + quad * 4 + jj; const unsigned pw = (jj < 2) ? yq.x : yq.y; const float yv = (jj & 1) ? bf_hi(pw) : bf_lo(pw);
                    ymix[(size_t)(row0 + io) * 1024 + 768 + ch] = f2bf(yv * rinv[jj] * w);
                }
            }
        __syncthreads();
    }
}

__device__ __forceinline__ void attn_tables(const Args& a, LAS unsigned char* lds, int layer) {
    const int tid = ltid(), lane = tid & 63, wave = __builtin_amdgcn_readfirstlane(tid >> 6);
#pragma unroll
    for (int hb = 0; hb < 2; ++hb) {
        LAS float* rpl = (LAS float*)(lds + 1024) + (wave * 2 + hb) * 512;
        const float* src = a.rpb + (size_t)(layer * 8 + (wave & 3) + 4 * hb) * 465;
        for (int i = lane; i < 512; i += 64) rpl[i] = 0.f;
        for (int i = lane; i < 465; i += 64) rpl[(i / 31) * 32 + (i % 31)] = src[i] * 1.4426950408889634f;
    }
}
__device__ __forceinline__ void attn_item(const Args& a, LAS unsigned char* lds, int layer, int b, int j) {
    const int tid = ltid(), lane = tid & 63, wave = __builtin_amdgcn_readfirstlane(tid >> 6);
    const int hb = j & 1, h = (wave & 3) + 4 * hb, jp = wave >> 2;
    LAS const float* rpl = (LAS const float*)(lds + 1024) + (wave * 2 + hb) * 512;
    LAS bf16_t* qls = (LAS bf16_t*)(lds + 1024 + 32768 + 1024) + wave * 32 * 72;
    if (j < 128) attn_row<true>(a, b, j >> 1, jp, h, lane, rpl, qls);
    else attn_row<false>(a, b, ((j - 128) >> 1) * 2 + jp, 0, h, lane, rpl, qls);
}
__device__ __forceinline__ void phase_mix(const Args& a, LAS unsigned char* lds, int layer, int rep = 0) {
    unsigned* ctr = (unsigned*)(a.ws + WS_BAR + 16384) + layer * 64 + rep * 32;
    LAS volatile int* qslot = (LAS volatile int*)(lds + LDS_BYTES - 64);
    const int tid = ltid();
    const int cfirst = (layer == DEPTH - 1) ? 2 : 0, ncu = NCH - cfirst, n_s3 = NB * ncu;
    const int nper = 128 + (layer < DEPTH - 1 ? 8 : 0), total = n_s3 + NB * nper;
    const int natt = NB * nper; (void)total;
    int nxt = 0;
    if (tid == 0) nxt = (int)__hip_atomic_fetch_add(ctr, 1u, __ATOMIC_RELAXED, __HIP_MEMORY_SCOPE_AGENT);
#pragma unroll 1
    for (;;) {
        __syncthreads();
        if (tid == 0) *qslot = nxt;
        __syncthreads();
        const int item = __builtin_amdgcn_readfirstlane(*qslot);
        if (item >= n_s3) break;
        if (tid == 0) nxt = (int)__hip_atomic_fetch_add(ctr, 1u, __ATOMIC_RELAXED, __HIP_MEMORY_SCOPE_AGENT);
        s3_unit(a, lds, layer, item / ncu, cfirst + item % ncu);
    }
    if (tid == 0) nxt = (int)__hip_atomic_fetch_add(ctr + 16, 1u, __ATOMIC_RELAXED, __HIP_MEMORY_SCOPE_AGENT);
    __syncthreads();
    attn_tables(a, lds, layer);
#pragma unroll 1
    for (;;) {
        __syncthreads();
        if (tid == 0) *qslot = nxt;
        __syncthreads();
        const int item = __builtin_amdgcn_readfirstlane(*qslot);
        if (item >= natt) break;
        if (tid == 0) nxt = (int)__hip_atomic_fetch_add(ctr + 16, 1u, __ATOMIC_RELAXED, __HIP_MEMORY_SCOPE_AGENT);
        attn_item(a, lds, layer, item / nper, item % nper);
    }
}

struct EpiU {
    static constexpr bool PERM = true, AFTER_DRAIN = false;
    bf16_t* U; bf16_t* KB;
    __device__ __forceinline__ void operator()(const pg8::f32x4 (&acc)[2][2][4][2], const pg8::Unit& un, int wr, int wc, int fr, int fq) const {
        const int pn = un.pn, pm = un.pm;
        const bool isk = (pn == 6 || pn == 7);
        const bool lat = pm < 128;
        const int b = lat ? (pm >> 4) : (pm - 128), blk0 = lat ? (pm & 15) * 8 : 0;
        const unsigned hstride = lat ? 128u * 2048u : 8u * 2048u;
        bf16_t* kbase = KB + (lat ? (size_t)0 : KB_CTX) + (size_t)(b * 8) * hstride;
#pragma unroll
        for (int ai = 0; ai < 2; ++ai)
#pragma unroll
            for (int m = 0; m < 4; ++m) {
                const int rl = ai * 128 + wr * 64 + m * 16 + fr;
                const int kin = rl & 31, o = (kin >> 2) & 1, rho = (kin >> 3) * 4 + (kin & 3);
                const unsigned koff = (unsigned)(blk0 + (rl >> 5)) * 2048u + (unsigned)((o * 2) * 16 + rho) * 32u;
                bf16_t* rowp = U + (size_t)(pm * 256 + rl) * ULD + (pn < 6 ? pn : pn - 2) * 256 + wc * 32 + 8 * fq;
#pragma unroll
                for (int bj = 0; bj < 2; ++bj) {
                    const pg8::f32x4 v0 = acc[ai][bj][m][0], v1 = acc[ai][bj][m][1];
                    u32x4 w; w.x = pk2(v0[0], v0[1]); w.y = pk2(v0[2], v0[3]); w.z = pk2(v1[0], v1[1]); w.w = pk2(v1[2], v1[3]);
                    const int h = (pn - 6) * 4 + bj * 2 + (wc >> 1), kk = wc & 1;
                    bf16_t* dst = isk ? kbase + (size_t)((unsigned)h * hstride + koff + (unsigned)(kk * 16 * 32 + 8 * fq)) : rowp + bj * 128;
                    *(u32x4*)dst = w;
                }
            }
    }
};

constexpr int PH_PER_LAYER = 7, N_PHASES = 2 + PH_PER_LAYER * DEPTH;
__device__ __forceinline__ void run_phase(const Args& a, LAS unsigned char* lds, int ph) {
    if (ph == 0) { phase_adaln(a, lds); convert_layer_weights(a, lds, 0); return; }
    if (ph == 1) { phase_rows(a, lds, -1, 0); return; }
    const int layer = (ph - 2) / PH_PER_LAYER, k = (ph - 2) % PH_PER_LAYER;
#ifndef REPK
#define REPK -1
#endif
    const int nrep = (k == REPK) ? 2 : 1;
    for (int rep = 0; rep < nrep; ++rep) {
    if (k == 0) {
        pg8::Gemm g{(const pg8::bf16_t*)(a.ws + WS_H), (const pg8::bf16_t*)(a.ws + WS_WIN), TT, NU, DM}; pg8::StaticOrder S; S.init(TT, NU, (int)gridDim.x, (int)blockIdx.x);
        EpiU E{(bf16_t*)(a.ws + WS_U), (bf16_t*)(a.ws + WS_KB)};
        pg8::gemm_phase<EpiU, pg8::StaticOrder>(lds, g, S, E, nullptr);
    } else if (k == 1) phase_prep(a, lds, layer);
    else if (k == 2) phase_s1(a, lds, layer);
    else if (k == 3) { if (rep == 0) phase_scan(a); }
    else if (k == 4) phase_mix(a, lds, layer, rep);
    else if (k == 5) {
        const int mrows = (layer == DEPTH - 1) ? TL : TT;
        pg8::Gemm g{(const pg8::bf16_t*)(a.ws + WS_H), (const pg8::bf16_t*)(a.ws + WS_WOUT), mrows, DM, DM}; pg8::StaticOrder S; S.init(mrows, DM, (int)gridDim.x, (int)blockIdx.x);
        pg8::EpiBf16<0> E{(pg8::bf16_t*)(a.ws + WS_U), DM, nullptr, 0, 0};
        pg8::gemm_phase<pg8::EpiBf16<0>, pg8::StaticOrder>(lds, g, S, E, nullptr);
        if (rep == 0 && layer + 1 < DEPTH) convert_win_queued(a, lds, layer + 1, (unsigned*)(a.ws + WS_BAR + 16384) + layer * 64 + 48);
    } else if (rep == 0) {
        if (REPK == 6) { phase_rows(a, lds, -1, layer + 1 < DEPTH ? layer + 1 : 0); __syncthreads(); }
        phase_rows(a, lds, layer, layer + 1 < DEPTH ? layer + 1 : -1);
        if (layer + 1 < DEPTH) { __syncthreads(); convert_wT(a.w_out + (size_t)(layer + 1) * 1024 * 1024, 1024, 1024, (bf16_t*)(a.ws + WS_WOUT), lds); }
    }
    if (REPK >= 0) __syncthreads();
    }
}

template <bool COOP>
__global__ void __launch_bounds__(512) mk_fwd(Args a) {
    extern __shared__ __attribute__((aligned(16))) unsigned char lds_raw[];
    LAS unsigned char* lds = (LAS unsigned char*)lds_raw;
    XcdBarrier bar; bar.bar = nullptr; bar.x = 0; bar.st = nullptr;
    if (COOP) {
        volatile LAS unsigned* stw = (volatile LAS unsigned*)(lds + LDS_BYTES - 16);
        if (threadIdx.x == 0) { stw[0] = 0u; stw[1] = 0u; }
        __syncthreads();
        bar = xcd_barrier_post((unsigned*)(a.ws + WS_BAR), stw);
    }
    for (int ph = a.ph_lo; ph < a.ph_hi; ++ph) {
        run_phase(a, lds, ph);
        if (COOP) {
            if (ph + 1 < a.ph_hi) { if (a.ph_lo > 0 && ph == a.ph_lo) cg::this_grid().sync(); else xcd_barrier(bar); }
        } else __syncthreads();
    }
}

extern "C" void kernel_launch(void* const* d_in, const int* in_sizes, int n_in, void* d_out, int out_size, void* d_ws, size_t ws_size, hipStream_t stream) {
    static int grid = 0;
    if (grid == 0) {
        if (n_in != 20 || ws_size < WS_END) { fprintf(stderr, "kernel_launch: unexpected n_in %d or ws_size %zu (< %zu)\n", n_in, ws_size, (size_t)WS_END); grid = -1; return; }
        int dev = 0, cus = 0, per_cu = 0;
        hipGetDevice(&dev); hipDeviceGetAttribute(&cus, hipDeviceAttributeMultiprocessorCount, dev);
        hipFuncSetAttribute((const void*)mk_fwd<true>, hipFuncAttributeMaxDynamicSharedMemorySize, LDS_BYTES);
        hipFuncSetAttribute((const void*)mk_fwd<false>, hipFuncAttributeMaxDynamicSharedMemorySize, LDS_BYTES);
        hipOccupancyMaxActiveBlocksPerMultiprocessor(&per_cu, (const void*)mk_fwd<true>, 512, LDS_BYTES);
        if (per_cu < 1) { fprintf(stderr, "kernel_launch: occupancy query reports %d blocks per CU\n", per_cu); per_cu = 1; }
        (void)hipGetLastError();
        grid = cus * 1;
        if (grid <= 0) grid = 256;
    }
    if (grid < 0) return;
    Args a{};
    a.x = (const float*)d_in[0]; a.c = (const float*)d_in[1]; a.ctx = (const float*)d_in[2]; a.c_ctx = (const float*)d_in[3]; a.w_ada = (const float*)d_in[4];
    a.b_ada = (const float*)d_in[5]; a.g_pre = (const float*)d_in[6]; a.g_post = (const float*)d_in[7]; a.w_in = (const float*)d_in[8]; a.conv_a_w = (const float*)d_in[9];
    a.rpb = (const float*)d_in[10]; a.ssd_conv_w = (const float*)d_in[11]; a.ssd_conv_b = (const float*)d_in[12]; a.dt_bias_f = (const float*)d_in[13];
    a.dt_bias_b = (const float*)d_in[14]; a.a_log_f = (const float*)d_in[15]; a.a_log_b = (const float*)d_in[16]; a.ssd_d = (const float*)d_in[17];
    a.ssd_norm_w = (const float*)d_in[18]; a.w_out = (const float*)d_in[19];
    a.out = (float*)d_out; a.ws = (unsigned char*)d_ws;
    if (hipMemsetAsync((char*)d_ws + WS_BAR, 0, 16384 + 1024, stream) != hipSuccess) { fprintf(stderr, "kernel_launch: memset of barrier words failed\n"); return; }
#if MK_ONE_LAUNCH
    a.ph_lo = 0; a.ph_hi = N_PHASES;
    void* args[] = {&a};
    hipError_t e = hipLaunchCooperativeKernel((const void*)mk_fwd<true>, dim3(grid), dim3(512), args, LDS_BYTES, stream);
    if (e != hipSuccess) fprintf(stderr, "cooperative launch failed: %s (grid %d)\n", hipGetErrorString(e), grid);
#else
    for (int ph = 0; ph < N_PHASES; ++ph) {
        a.ph_lo = ph; a.ph_hi = ph + 1;
        hipLaunchKernelGGL(mk_fwd<false>, dim3(grid), dim3(512), LDS_BYTES, stream, a);
    }
#endif
}
```

```cpp
#include <hip/hip_runtime.h>
#include <hip/hip_cooperative_groups.h>
#include <cstdio>
namespace cg = cooperative_groups;
namespace pg8 {
#define PG8_LAS __attribute__((address_space(3)))
typedef unsigned short bf16_t;
typedef short bf16x8 __attribute__((ext_vector_type(8)));
typedef float f32x4 __attribute__((ext_vector_type(4)));
typedef unsigned u32x4 __attribute__((ext_vector_type(4)));
constexpr int BM = 256, BK = 64, HALF = 128, HTB = HALF * BK * 2  , STAGE_BYTES = 8 * HTB, NXCD = 8, WGM = 8;

__host__ __device__ __forceinline__ int lds_byte(int r, int c) { const int st = (r >> 4) * 2 + (c >> 5), rr = r & 15, cc = c & 31, ob = rr * 64 + cc * 2; return st * 1024 + (ob ^ (((ob >> 9) & 1) << 5)); }
__host__ __device__ __forceinline__ void stage_rc(int b, int& R, int& C) { const int st = b / 1024, sb = b % 1024, swz = sb ^ (((sb >> 9) & 1) << 5); R = (st >> 1) * 16 + swz / 64; C = (st & 1) * 32 + (swz % 64) / 2; }
__host__ __device__ __forceinline__ int perm32(int rho) { const int n = rho >> 4, i = rho & 15; return 8 * (i >> 2) + 4 * n + (i & 3); }

struct Unit { int pm, pn; };
struct Gemm { const bf16_t* A; const bf16_t* Bt; int M, N, K; };

struct StaticOrder {
    int nM, nN, nwg, G, c;
    __host__ __device__ void init(int M, int N, int G_, int c_) { nM = M / BM; nN = N / BM; nwg = nM * nN; G = G_; c = c_; }
    __host__ __device__ bool next(int i, Unit& u) const {
        const long L = (long)i * G + c; if (L >= nwg) return false;
        int wgid = (int)L; { const int q = nwg / NXCD, r = nwg % NXCD, xcd = wgid % NXCD, off = wgid / NXCD; wgid = (xcd < r ? xcd * (q + 1) : r * (q + 1) + (xcd - r) * q) + off; }
        const int nig = WGM * nN, gid = wgid / nig, fm = gid * WGM, gsz = (nM - fm) < WGM ? (nM - fm) : WGM;
        u.pm = fm + ((wgid % nig) % gsz); u.pn = (wgid % nig) / gsz; return true;
    }
    __device__ __forceinline__ void a_ready(const Unit&) const {}
    __device__ __forceinline__ void done(const Unit&) const {}
};

typedef float f32x2c __attribute__((ext_vector_type(2))); typedef __bf16 bf16x2c __attribute__((ext_vector_type(2)));
__device__ __forceinline__ unsigned cvt_pk_bf16(float lo, float hi) { const f32x2c v = {lo, hi}; return __builtin_bit_cast(unsigned, __builtin_convertvector(v, bf16x2c)); }
typedef float f32x2 __attribute__((ext_vector_type(2)));
__device__ __forceinline__ f32x2 gelu_pk(f32x2 v) {
    const f32x2 av = __builtin_elementwise_abs(v), d = av * 0.2316418882f + 1.0f;
    f32x2 t; t.x = __builtin_amdgcn_rcpf(d.x); t.y = __builtin_amdgcn_rcpf(d.y);
    f32x2 q = t * 0.5307027145f + (-0.7265760135f); q = q * t + 0.7107068705f; q = q * t + (-0.142248368f); q = q * t + 0.127414796f; q = q * t;
    const f32x2 s = (v * v) * (-0.72134752044f);
    f32x2 e; e.x = __builtin_amdgcn_exp2f(s.x); e.y = __builtin_amdgcn_exp2f(s.y);
    const f32x2 m = v * (q * e), r = v - m;
    f32x2 o; o.x = v.x < 0.f ? m.x : r.x; o.y = v.y < 0.f ? m.y : r.y; return o;
}

struct EpiF32 {
    static constexpr bool PERM = false, AFTER_DRAIN = false;
    float* C; int ldc; const float* bias;
    __device__ __forceinline__ void operator()(const f32x4 (&acc)[2][2][4][2], const Unit& u, int wr, int wc, int fr, int fq) const {
        const int row0 = u.pm * BM + wr * 64 + fr, col0 = u.pn * BM + wc * 32 + 4 * fq;
        f32x4 bv[2][2];
#pragma unroll
        for (int bj = 0; bj < 2; ++bj)
#pragma unroll
            for (int n = 0; n < 2; ++n) bv[bj][n] = bias ? *(const f32x4*)(bias + col0 + bj * HALF + n * 16) : (f32x4){0.f, 0.f, 0.f, 0.f};
#pragma unroll
        for (int ai = 0; ai < 2; ++ai)
#pragma unroll
            for (int m = 0; m < 4; ++m) { float* rowp = C + (size_t)(row0 + ai * HALF + m * 16) * ldc + col0;
#pragma unroll
                for (int bj = 0; bj < 2; ++bj)
#pragma unroll
                    for (int n = 0; n < 2; ++n) *(f32x4*)(rowp + bj * HALF + n * 16) = acc[ai][bj][m][n] + bv[bj][n]; }
    }
};
template <int ACT  > struct EpiBf16 {
    static constexpr bool PERM = true, AFTER_DRAIN = false;
    bf16_t* O; int ldc; const float* bias; int split_cols; size_t split_stride;
    __device__ __forceinline__ void operator()(const f32x4 (&acc)[2][2][4][2], const Unit& u, int wr, int wc, int fr, int fq) const {
        const int row0 = u.pm * BM + wr * 64 + fr; int colt = u.pn * BM; bf16_t* base = O;
        if (split_cols) { const int t = colt / split_cols; base += (size_t)t * split_stride; colt -= t * split_cols; }
        const int col0 = colt + wc * 32 + 8 * fq, bcol0 = u.pn * BM + wc * 32 + 8 * fq;
        f32x4 bv[2][2];
#pragma unroll
        for (int bj = 0; bj < 2; ++bj)
#pragma unroll
            for (int n = 0; n < 2; ++n) bv[bj][n] = bias ? *(const f32x4*)(bias + bcol0 + bj * HALF + 4 * n) : (f32x4){0.f, 0.f, 0.f, 0.f};
#pragma unroll
        for (int ai = 0; ai < 2; ++ai)
#pragma unroll
            for (int m = 0; m < 4; ++m) { bf16_t* rowp = base + (size_t)(row0 + ai * HALF + m * 16) * ldc + col0;
#pragma unroll
                for (int bj = 0; bj < 2; ++bj) { f32x4 v0 = acc[ai][bj][m][0] + bv[bj][0], v1 = acc[ai][bj][m][1] + bv[bj][1];
                    if (ACT == 1) { f32x2 a = gelu_pk((f32x2){v0[0], v0[1]}), b = gelu_pk((f32x2){v0[2], v0[3]}), c = gelu_pk((f32x2){v1[0], v1[1]}), d = gelu_pk((f32x2){v1[2], v1[3]});
                        v0 = (f32x4){a.x, a.y, b.x, b.y}; v1 = (f32x4){c.x, c.y, d.x, d.y}; }
                    if (ACT == 2) {
#pragma unroll
                        for (int j = 0; j < 4; ++j) { v0[j] = 0.5f * v0[j] * (1.0f + erff(v0[j] * 0.70710678f)); v1[j] = 0.5f * v1[j] * (1.0f + erff(v1[j] * 0.70710678f)); } }
                    u32x4 w; w.x = cvt_pk_bf16(v0[0], v0[1]); w.y = cvt_pk_bf16(v0[2], v0[3]); w.z = cvt_pk_bf16(v1[0], v1[1]); w.w = cvt_pk_bf16(v1[2], v1[3]);
                    *(u32x4*)(rowp + bj * HALF) = w; } }
    }
};
template <class Epi, class Sched, bool STAMP = false>
__device__ __forceinline__ void gemm_phase(PG8_LAS unsigned char* lds, const Gemm g, const Sched& S, const Epi& E, unsigned long long* stamps) {
    int tid_l = threadIdx.x; asm volatile("" : "+v"(tid_l)); const int tid = tid_l, wid = __builtin_amdgcn_readfirstlane(tid >> 6), lane = tid & 63, wr = wid >> 2, wc = wid & 3, fr = lane & 15, fq = lane >> 4;
    const int K = g.K, nt = K / BK;
    int ts_lo = 0, ts_hi = 0, nts = 0; const unsigned long long rt_entry = STAMP ? (unsigned long long)wall_clock64() : 0ull;
#define PG8_STAMP() do { if (STAMP && wid == 0 && nts < 64) { const unsigned long long _c = (unsigned long long)clock64(); \
        ts_lo = (lane == nts) ? (int)(unsigned)_c : ts_lo; ts_hi = (lane == nts) ? (int)(unsigned)(_c >> 32) : ts_hi; ++nts; } } while (0)
    PG8_STAMP();
    unsigned voffA[2], voffB[2];
#pragma unroll
    for (int i = 0; i < 2; ++i) { int R, C; stage_rc(tid * 16 + i * 8192, R, C); const int Rb = Epi::PERM ? ((R & ~31) + perm32(R & 31)) : R;
        voffA[i] = (unsigned)(R * K + C) * 2u; voffB[i] = (unsigned)(Rb * K + C) * 2u; }
    const size_t kstep = (size_t)(BK * 2);
    const size_t hstep = (size_t)HALF * K * 2;
    const size_t tstep = 2 * hstep;
    const unsigned ldsw = (unsigned)wid * 1024u;
    const int aoff = lds_byte(wr * 64 + fr, fq * 8), boff = lds_byte(wc * 32 + fr, fq * 8);
#define PG8_SA(b, h) (((b) * 2 + (h)) * HTB)
#define PG8_SB(b, h) ((4 + (b) * 2 + (h)) * HTB)
#define PG8_STAGE(bufoff, gbase, voff) do { _Pragma("unroll") for (int _i = 0; _i < 2; ++_i) \
        __builtin_amdgcn_global_load_lds((const unsigned*)((const char*)(gbase) + (voff)[_i]), (PG8_LAS unsigned*)(lds + (bufoff) + ldsw + _i * 8192), 16, 0, 0); } while (0)
#define PG8_LDA(dst, b, h) do { _Pragma("unroll") for (int m = 0; m < 4; ++m) _Pragma("unroll") for (int k = 0; k < 2; ++k) dst[m][k] = *(const PG8_LAS bf16x8*)(lds + PG8_SA(b, h) + aoff + m * 2048 + k * 1024); } while (0)
#define PG8_LDB(dst, b, h) do { _Pragma("unroll") for (int n = 0; n < 2; ++n) _Pragma("unroll") for (int k = 0; k < 2; ++k) dst[n][k] = *(const PG8_LAS bf16x8*)(lds + PG8_SB(b, h) + boff + n * 2048 + k * 1024); } while (0)
#define PG8_MMA(ai, bj, At, Bt) do { __builtin_amdgcn_s_setprio(1); _Pragma("unroll") for (int m = 0; m < 4; ++m) _Pragma("unroll") for (int n = 0; n < 2; ++n) _Pragma("unroll") for (int k = 0; k < 2; ++k) \
        acc[ai][bj][m][n] = __builtin_amdgcn_mfma_f32_16x16x32_bf16(Bt[n][k], At[m][k], acc[ai][bj][m][n], 0, 0, 0); __builtin_amdgcn_s_setprio(0); } while (0)
#define PG8_WAIT_V(n) asm volatile("s_waitcnt vmcnt(" #n ")" ::: "memory")
#define PG8_WAIT_L(n) asm volatile("s_waitcnt lgkmcnt(" #n ")" ::: "memory")
#define PG8_BAR __builtin_amdgcn_s_barrier()
#define PG8_SCHED __builtin_amdgcn_sched_barrier(0)
    Unit cur, nxt; int ui = 0;
    if (!S.next(0, cur)) return;
    f32x4 acc[2][2][4][2];
#pragma unroll
    for (int a = 0; a < 2; ++a)
#pragma unroll
        for (int b = 0; b < 2; ++b)
#pragma unroll
            for (int m = 0; m < 4; ++m)
#pragma unroll
                for (int n = 0; n < 2; ++n) acc[a][b][m][n] = (f32x4){0.f, 0.f, 0.f, 0.f};
    bf16x8 At[4][2], B0[2][2], B1[2][2];
    const char* cA = (const char*)g.A + (size_t)cur.pm * tstep; const char* cB = (const char*)g.Bt + (size_t)cur.pn * tstep;
    S.a_ready(cur);
    PG8_STAGE(PG8_SB(0, 0), cB, voffB); PG8_STAGE(PG8_SA(0, 0), cA, voffA); PG8_STAGE(PG8_SB(0, 1), cB + hstep, voffB); PG8_STAGE(PG8_SA(0, 1), cA + hstep, voffA);
    if (wr == 1) PG8_BAR;
    PG8_WAIT_V(4); PG8_BAR;
    PG8_STAGE(PG8_SB(1, 0), cB + kstep, voffB); PG8_STAGE(PG8_SA(1, 0), cA + kstep, voffA); PG8_STAGE(PG8_SB(1, 1), cB + hstep + kstep, voffB);
    PG8_WAIT_V(6); PG8_BAR;
    PG8_STAMP();
    for (;;) {
        const bool has_next = S.next(ui + 1, nxt);
        const char* nA = has_next ? (const char*)g.A + (size_t)nxt.pm * tstep : cA; const char* nB = has_next ? (const char*)g.Bt + (size_t)nxt.pn * tstep : cB;
        for (int t = 0; t < nt; t += 2) {
            const bool last = (t == nt - 2);
            const char* a1 = cA + (size_t)(t + 1) * kstep;
            const char* a2 = last ? nA : cA + (size_t)(t + 2) * kstep; const char* b2 = last ? nB : cB + (size_t)(t + 2) * kstep;
            const char* a3 = a2 + kstep; const char* b3 = b2 + kstep;
            if (last && has_next) S.a_ready(nxt);
            PG8_LDB(B0, 0, 0); PG8_SCHED; PG8_LDA(At, 0, 0); PG8_STAGE(PG8_SA(1, 1), a1 + hstep, voffA);
            PG8_WAIT_L(8); PG8_BAR; PG8_WAIT_L(0); PG8_MMA(0, 0, At, B0); PG8_BAR; PG8_SCHED;
            PG8_LDB(B1, 0, 1); PG8_STAGE(PG8_SB(0, 0), b2, voffB);
            PG8_BAR; PG8_WAIT_L(0); PG8_MMA(0, 1, At, B1); PG8_BAR;
            PG8_LDA(At, 0, 1); PG8_STAGE(PG8_SA(0, 0), a2, voffA);
            PG8_BAR; PG8_WAIT_L(0); PG8_MMA(1, 0, At, B0); PG8_BAR; PG8_SCHED;
            PG8_STAGE(PG8_SB(0, 1), b2 + hstep, voffB);
            PG8_WAIT_V(6); PG8_BAR; PG8_MMA(1, 1, At, B1); PG8_BAR;
            PG8_LDB(B0, 1, 0); PG8_SCHED; PG8_LDA(At, 1, 0); PG8_STAGE(PG8_SA(0, 1), a2 + hstep, voffA);
            PG8_WAIT_L(8); PG8_BAR; PG8_WAIT_L(0); PG8_MMA(0, 0, At, B0); PG8_BAR; PG8_SCHED;
            PG8_LDB(B1, 1, 1); PG8_STAGE(PG8_SB(1, 0), b3, voffB);
            PG8_BAR; PG8_WAIT_L(0); PG8_MMA(0, 1, At, B1); PG8_BAR;
            PG8_LDA(At, 1, 1); PG8_STAGE(PG8_SA(1, 0), a3, voffA);
            PG8_BAR; PG8_WAIT_L(0); PG8_MMA(1, 0, At, B0); PG8_BAR; PG8_SCHED;
            PG8_STAGE(PG8_SB(1, 1), b3 + hstep, voffB);
            PG8_WAIT_V(6); PG8_BAR; PG8_MMA(1, 1, At, B1); PG8_BAR;
        }
        PG8_STAMP();
        if constexpr (!Epi::AFTER_DRAIN) { E(acc, cur, wr, wc, fr, fq); S.done(cur); }
        PG8_STAMP();
        if (!has_next) break;
#pragma unroll
        for (int a = 0; a < 2; ++a)
#pragma unroll
            for (int b = 0; b < 2; ++b)
#pragma unroll
                for (int m = 0; m < 4; ++m)
#pragma unroll
                    for (int n = 0; n < 2; ++n) acc[a][b][m][n] = (f32x4){0.f, 0.f, 0.f, 0.f};
        cur = nxt; cA = nA; cB = nB; ++ui;
    }
    PG8_WAIT_V(0);
    if (wr == 0) PG8_BAR;
    PG8_BAR;
    if constexpr (Epi::AFTER_DRAIN) { E.fused(acc, cur, wr, wc, fr, fq, lds, wid, lane); S.done(cur); }
    PG8_STAMP();
    if (STAMP && wid == 0) { stamps[lane] = lane < nts ? (((unsigned long long)(unsigned)ts_hi << 32) | (unsigned)ts_lo) : 0ull;
        if (lane == 62) stamps[62] = rt_entry; if (lane == 63) stamps[63] = (unsigned long long)wall_clock64(); }
#undef PG8_STAMP
#undef PG8_SA
#undef PG8_SB
#undef PG8_STAGE
#undef PG8_LDA
#undef PG8_LDB
#undef PG8_MMA
#undef PG8_WAIT_V
#undef PG8_WAIT_L
#undef PG8_BAR
#undef PG8_SCHED
}
}

#ifndef MK_ONE_LAUNCH
#define MK_ONE_LAUNCH 1
#endif
#define LAS __attribute__((address_space(3)))
typedef unsigned short bf16_t;
typedef short bf16x8 __attribute__((ext_vector_type(8)));
typedef short s16x4 __attribute__((ext_vector_type(4)));
typedef float f32x4 __attribute__((ext_vector_type(4)));
typedef unsigned u32x4 __attribute__((ext_vector_type(4)));
typedef unsigned u32x2 __attribute__((ext_vector_type(2)));

#define XB_TMO      128
#define XB_XCNT(j)  (256  + 64 * (j))
#define XB_XSUB(j)  (1280 + 64 * (j))
#define XB_XGEN(j)  (2304 + 64 * (j))
#define XB_TOP      3328
#define XB_TOPGEN   3392
#define XCD_BAR_WORDS 3456
#define XB_SPIN_CAP (1u << 18)

__device__ __forceinline__ unsigned xb_ld(unsigned* p)              { return __hip_atomic_load(p, __ATOMIC_RELAXED, __HIP_MEMORY_SCOPE_AGENT); }
__device__ __forceinline__ unsigned xb_add(unsigned* p, unsigned v) { return __hip_atomic_fetch_add(p, v, __ATOMIC_RELAXED, __HIP_MEMORY_SCOPE_AGENT); }
__device__ __forceinline__ unsigned xb_xcc_id() { return (unsigned)__builtin_amdgcn_s_getreg((3 << 11) | 20) & 0xFu; }
#define XB_SPIN(cond, bar) do { unsigned _sp = 0; while (cond) { __builtin_amdgcn_s_sleep(1); \
    if ((++_sp & 255u) == 0u) { if (xb_ld(&(bar)[XB_TMO])) break; if (_sp > XB_SPIN_CAP) { atomicAdd(&(bar)[XB_TMO], 1u); break; } } } } while (0)

struct XcdBarrier {
    unsigned* bar; unsigned x;
    volatile LAS unsigned* st;
};

__device__ __forceinline__ XcdBarrier xcd_barrier_post(unsigned* bar, volatile LAS unsigned* st) {
    XcdBarrier b; b.bar = bar; b.x = xb_xcc_id(); b.st = st;
    if (threadIdx.x == 0) (void)xb_add(&bar[XB_XCNT(b.x)], 1u);
    return b;
}
__device__ __forceinline__ void xcd_barrier_complete(unsigned* bar, unsigned x, unsigned& nloc, unsigned& nx) {
    const unsigned G = gridDim.x * gridDim.y * gridDim.z;
    unsigned sum, cnt, mine, sp = 0u;
    for (;;) {
        sum = 0u; cnt = 0u; mine = 0u;
#pragma unroll
        for (unsigned j = 0; j < 16; ++j) { const unsigned c = xb_ld(&bar[XB_XCNT(j)]); sum += c; cnt += (c > 0u) ? 1u : 0u; mine = (j == x) ? c : mine; }
        if (sum == G) break;
        __builtin_amdgcn_s_sleep(1);
        if ((++sp & 255u) == 0u) { if (xb_ld(&bar[XB_TMO])) break; if (sp > XB_SPIN_CAP) { atomicAdd(&bar[XB_TMO], 1u); break; } }
    }
    nloc = mine > 0u ? mine : 1u; nx = cnt > 0u ? cnt : 1u;
}

__device__ __forceinline__ void xcd_barrier(const XcdBarrier& b) {
    asm volatile("s_waitcnt vmcnt(0)" ::: "memory");
    __syncthreads();
    if (threadIdx.x == 0) {
        unsigned* bar = b.bar;
        __builtin_amdgcn_s_waitcnt(0);
        unsigned nloc = b.st[0], nx = b.st[1];
        if (nloc == 0u) { xcd_barrier_complete(bar, b.x, nloc, nx); b.st[0] = nloc; b.st[1] = nx; }
        const unsigned old = xb_add(&bar[XB_XSUB(b.x)], 1u);
        const unsigned gen = old / nloc;
        if (old + 1u == (gen + 1u) * nloc) {
            __builtin_amdgcn_fence(__ATOMIC_RELEASE, "agent");
            asm volatile("s_waitcnt vmcnt(0)" ::: "memory");
            const unsigned og = xb_add(&bar[XB_TOP], 1u);
            const unsigned tg = og / nx;
            if (og + 1u == (tg + 1u) * nx) xb_add(&bar[XB_TOPGEN], 1u);
            else XB_SPIN(xb_ld(&bar[XB_TOPGEN]) == tg, bar);
            __builtin_amdgcn_fence(__ATOMIC_ACQUIRE, "agent");
            xb_add(&bar[XB_XGEN(b.x)], 1u);
            asm volatile("s_waitcnt vmcnt(0)" ::: "memory");
        } else {
            XB_SPIN(xb_ld(&bar[XB_XGEN(b.x)]) == gen, bar);
            __builtin_amdgcn_fence(__ATOMIC_ACQUIRE, "agent");
            asm volatile("s_waitcnt vmcnt(0)" ::: "memory");
        }
    }
    __syncthreads();
}

constexpr int DM = 1024, NB = 8, SEQ = 4096, DEPTH = 4, CTXL = 256;
constexpr int TL = NB * SEQ, TCX = NB * CTXL, TT = TL + TCX;
constexpr int INW = 4104, NU = 4096, ULD = 3584, VLD = 4096, NCH = 34;
constexpr int U_SCIN = 0, U_SCB = 256, U_SCC = 512, U_SCZ = 768, U_Q = 1024, U_V = 1536, U_NAZ = 2048, U_XBC = 2560, U_SSZ = 3328;
constexpr float EPSN = 1e-6f;
constexpr int NB_ = 8;
constexpr int LDS_BYTES = 150 * 1024;
constexpr int XS_LD = 272;
constexpr size_t VT_CTX = (size_t)NB_ * 8 * 64 * VLD;
constexpr size_t KB_CTX = (size_t)NB_ * 8 * 128 * 2048;

constexpr size_t MiB = 1u << 20;
constexpr size_t WS_WIN = 0, WS_WOUT = WS_WIN + 8 * MiB, WS_MOD = WS_WOUT + 2 * MiB, WS_H = WS_MOD + 1 * MiB, WS_U = WS_H + 68 * MiB,
                 WS_KB = WS_U + 238 * MiB, WS_XBC = WS_U + 277 * MiB, WS_ST = WS_XBC + 51 * MiB, WS_VT = WS_ST + 34 * MiB, WS_XCTX = WS_VT + 36 * MiB, WS_DTR = WS_XCTX + 8 * MiB,
                 WS_DTS = WS_DTR + 2 * MiB, WS_ACS = WS_DTS + 2 * MiB, WS_CDEC = WS_ACS + 2 * MiB, WS_BAR = WS_CDEC + 1 * MiB, WS_END = WS_BAR + 1 * MiB;

struct Args {
    const float* x; const float* c; const float* ctx; const float* c_ctx; const float* w_ada; const float* b_ada; const float* g_pre; const float* g_post;
    const float* w_in; const float* conv_a_w; const float* rpb; const float* ssd_conv_w; const float* ssd_conv_b; const float* dt_bias_f; const float* dt_bias_b;
    const float* a_log_f; const float* a_log_b; const float* ssd_d; const float* ssd_norm_w; const float* w_out;
    float* out; unsigned char* ws; int ph_lo, ph_hi;
};

__device__ __forceinline__ float bf_lo(unsigned w) { return __uint_as_float(w << 16); }
__device__ __forceinline__ float bf_hi(unsigned w) { return __uint_as_float(w & 0xffff0000u); }
__device__ __forceinline__ float bf2f(bf16_t v) { return __uint_as_float(((unsigned)v) << 16); }
typedef float f32x2_t __attribute__((ext_vector_type(2)));
typedef __bf16 bf16x2_t __attribute__((ext_vector_type(2)));
__device__ __forceinline__ unsigned pk2(float lo, float hi) { const f32x2_t v = {lo, hi}; return __builtin_bit_cast(unsigned, __builtin_convertvector(v, bf16x2_t)); }
__device__ __forceinline__ bf16_t f2bf(float f) { return (bf16_t)(pk2(f, 0.f) & 0xffffu); }
__device__ __forceinline__ float silu_f(float v) { return v / (1.f + __expf(-v)); }
__device__ __forceinline__ float softplus_f(float v) { return v > 15.f ? v : log1pf(__expf(v)); }
__device__ __forceinline__ f32x4 mfma16(bf16x8 a, bf16x8 b, f32x4 c) { return __builtin_amdgcn_mfma_f32_16x16x32_bf16(a, b, c, 0, 0, 0); }
__device__ __forceinline__ bf16x8 ldg8(const bf16_t* p) { return __builtin_bit_cast(bf16x8, *(const u32x4*)p); }
__device__ __forceinline__ bf16x8 pack8(const float (&f)[8]) { u32x4 v; v.x = pk2(f[0], f[1]); v.y = pk2(f[2], f[3]); v.z = pk2(f[4], f[5]); v.w = pk2(f[6], f[7]); return __builtin_bit_cast(bf16x8, v); }
__device__ __forceinline__ void unpack8(u32x4 v, float (&f)[8]) { f[0] = bf_lo(v.x); f[1] = bf_hi(v.x); f[2] = bf_lo(v.y); f[3] = bf_hi(v.y); f[4] = bf_lo(v.z); f[5] = bf_hi(v.z); f[6] = bf_lo(v.w); f[7] = bf_hi(v.w); }
__device__ __forceinline__ float wave_sum(float v) {
#pragma unroll
    for (int o = 32; o >= 1; o >>= 1) v += __shfl_xor(v, o);
    return v;
}
__device__ __forceinline__ int ltid() { int t = threadIdx.x; asm volatile("" : "+v"(t)); return t; }
__device__ __forceinline__ int chunk_row0(int b, int c) { return c < 2 ? TL + b * CTXL + c * 128 : b * SEQ + (c - 2) * 128; }

__device__ __forceinline__ void phase_adaln(const Args& a, LAS unsigned char* lds) {
    LAS float* sv = (LAS float*)lds;
    LAS float* red = (LAS float*)(lds + 36864);
    float* mod = (float*)(a.ws + WS_MOD);
    const int tid = ltid(), lane = tid & 63, wave = __builtin_amdgcn_readfirstlane(tid >> 6);
    for (int i = tid; i < 9 * 1024; i += 512) { const int r = i >> 10, k = i & 1023; const float v = r < 8 ? a.c[r * 1024 + k] : a.c_ctx[k]; sv[i] = silu_f(v); }
    __syncthreads();
    for (int unit = blockIdx.x; unit < 4 * 48; unit += gridDim.x) {
        const int l = unit / 48, cb = (unit % 48) * 64;
        const float* w = a.w_ada + (size_t)l * 1024 * 3072 + cb + lane;
        float acc[9];
#pragma unroll
        for (int r = 0; r < 9; ++r) acc[r] = 0.f;
#pragma unroll 4
        for (int kk = 0; kk < 128; ++kk) {
            const int k = wave * 128 + kk; const float wv = w[(size_t)k * 3072];
#pragma unroll
            for (int r = 0; r < 9; ++r) acc[r] += sv[r * 1024 + k] * wv;
        }
#pragma unroll
        for (int r = 0; r < 9; ++r) red[(wave * 9 + r) * 64 + lane] = acc[r];
        __syncthreads();
        for (int i = tid; i < 9 * 64; i += 512) {
            const int r = i >> 6, cl = i & 63; float s = 0.f;
#pragma unroll
            for (int w8 = 0; w8 < 8; ++w8) s += red[(w8 * 9 + r) * 64 + cl];
            mod[(l * 9 + r) * 3072 + cb + cl] = s + a.b_ada[l * 3072 + cb + cl];
        }
        __syncthreads();
    }
}

__device__ __forceinline__ void convert_wT(const float* src, int ld, int ncols, bf16_t* dst, LAS unsigned char* lds) {
    LAS bf16_t* tile = (LAS bf16_t*)lds;
    const int tid = ltid();
    const int ntiles = 16 * (ncols / 64);
    for (int ti = blockIdx.x; ti < ntiles; ti += gridDim.x) {
        const int k0 = (ti & 15) * 64, n0 = (ti >> 4) * 64;
        const int r = tid >> 4, c4 = (tid & 15) * 4;
#pragma unroll
        for (int i = 0; i < 2; ++i) {
            const int k = r + 32 * i;
            const float4 v = *(const float4*)(src + (size_t)(k0 + k) * ld + n0 + c4);
            tile[(c4 + 0) * 72 + k] = f2bf(v.x); tile[(c4 + 1) * 72 + k] = f2bf(v.y); tile[(c4 + 2) * 72 + k] = f2bf(v.z); tile[(c4 + 3) * 72 + k] = f2bf(v.w);
        }
        __syncthreads();
        const int n = tid >> 3, ks = (tid & 7) * 8;
        const u32x4 v = *(LAS u32x4*)(tile + n * 72 + ks);
        *(u32x4*)(dst + (size_t)(n0 + n) * 1024 + k0 + ks) = v;
        __syncthreads();
    }
}
__device__ __forceinline__ void convert_win_queued(const Args& a, LAS unsigned char* lds, int layer_next, unsigned* ctr) {
    LAS bf16_t* tile = (LAS bf16_t*)lds;
    LAS volatile int* qslot = (LAS volatile int*)(lds + LDS_BYTES - 64);
    const int tid = ltid();
    const float* src = a.w_in + (size_t)layer_next * 1024 * INW; bf16_t* dst = (bf16_t*)(a.ws + WS_WIN);
#pragma unroll 1
    for (;;) {
        __syncthreads();
        if (tid == 0) *qslot = (int)__hip_atomic_fetch_add(ctr, 1u, __ATOMIC_RELAXED, __HIP_MEMORY_SCOPE_AGENT);
        __syncthreads();
        const int ti = __builtin_amdgcn_readfirstlane(*qslot);
        if (ti >= 16 * 64) break;
        const int k0 = (ti & 15) * 64, n0 = (ti >> 4) * 64;
        const int r = tid >> 4, c4 = (tid & 15) * 4;
#pragma unroll
        for (int i = 0; i < 2; ++i) {
            const int k = r + 32 * i;
            const float4 v = *(const float4*)(src + (size_t)(k0 + k) * INW + n0 + c4);
            tile[(c4 + 0) * 72 + k] = f2bf(v.x); tile[(c4 + 1) * 72 + k] = f2bf(v.y); tile[(c4 + 2) * 72 + k] = f2bf(v.z); tile[(c4 + 3) * 72 + k] = f2bf(v.w);
        }
        __syncthreads();
        const int n = tid >> 3, ks = (tid & 7) * 8;
        *(u32x4*)(dst + (size_t)(n0 + n) * 1024 + k0 + ks) = *(LAS u32x4*)(tile + n * 72 + ks);
    }
}
__device__ __forceinline__ void convert_layer_weights(const Args& a, LAS unsigned char* lds, int layer) {
    convert_wT(a.w_in + (size_t)layer * 1024 * INW, INW, 4096, (bf16_t*)(a.ws + WS_WIN), lds);
    convert_wT(a.w_out + (size_t)layer * 1024 * 1024, 1024, 1024, (bf16_t*)(a.ws + WS_WOUT), lds);
}

__device__ __forceinline__ float4 ntload4(const float* p) { const f32x4 v = __builtin_nontemporal_load((const f32x4*)p); return make_float4(v[0], v[1], v[2], v[3]); }
__device__ __forceinline__ void ntstore4(float* p, const float4& v) { const f32x4 w = {v.x, v.y, v.z, v.w}; __builtin_nontemporal_store(w, (f32x4*)p); }
struct RowCtx {
    const Args* a; LAS float* wdt; LAS float* gpl; LAS float* gnl; LAS float* gateL; LAS float* shiftL; LAS float* scaleL;
    float* xctx; bf16_t* hb; float* dtr; const bf16_t* outp; const float* xlat; const float* xcx; int lpost, lnorm, lane;
};
__device__ __forceinline__ void rows_load(const RowCtx& c, int row, float4 (&xv)[4], u32x2 (&ov)[4]) {
    const float* xsrc = row < TL ? c.xlat + (size_t)row * 1024 : c.xcx + (size_t)(row - TL) * 1024;
#pragma unroll
    for (int j = 0; j < 4; ++j) { xv[j] = ntload4(xsrc + j * 256 + c.lane * 4); ov[j] = (c.lpost >= 0) ? *(const u32x2*)(c.outp + (size_t)row * 1024 + j * 256 + c.lane * 4) : (u32x2){0u, 0u}; }
}
__device__ __forceinline__ void rows_compute(const RowCtx& c, int row, float4 (&xv)[4], const u32x2 (&ov)[4]) {
    const Args& a = *c.a; const int lpost = c.lpost, lnorm = c.lnorm, lane = c.lane;
    LAS float* wdt = c.wdt; LAS float* gpl = c.gpl; LAS float* gnl = c.gnl; LAS float* gateL = c.gateL; LAS float* shiftL = c.shiftL; LAS float* scaleL = c.scaleL;
    float* xctx = c.xctx; bf16_t* hb = c.hb; float* dtr = c.dtr;
        const bool isctx = row >= TL; const int mb = isctx ? 8 : (row >> 12);
        float* xdst = isctx ? xctx + (size_t)(row - TL) * 1024 : a.out + (size_t)row * 1024;
        if (lpost >= 0) {
            float of[4][4]; float ss = 0.f;
#pragma unroll
            for (int j = 0; j < 4; ++j) { of[j][0] = bf_lo(ov[j].x); of[j][1] = bf_hi(ov[j].x); of[j][2] = bf_lo(ov[j].y); of[j][3] = bf_hi(ov[j].y); ss += of[j][0] * of[j][0] + of[j][1] * of[j][1] + of[j][2] * of[j][2] + of[j][3] * of[j][3]; }
            ss = wave_sum(ss); const float rinv = rsqrtf(ss * (1.f / 1024.f) + EPSN);
            LAS const float* gate = gateL + mb * 1024;
#pragma unroll
            for (int j = 0; j < 4; ++j) {
                const int e = j * 256 + lane * 4; const f32x4 g4 = *(LAS const f32x4*)(gpl + e), t4 = *(LAS const f32x4*)(gate + e);
                xv[j].x += t4[0] * (of[j][0] * rinv * g4[0]); xv[j].y += t4[1] * (of[j][1] * rinv * g4[1]); xv[j].z += t4[2] * (of[j][2] * rinv * g4[2]); xv[j].w += t4[3] * (of[j][3] * rinv * g4[3]);
                ntstore4(xdst + e, xv[j]);
            }
        }
        if (lnorm >= 0) {
            float ss = 0.f;
#pragma unroll
            for (int j = 0; j < 4; ++j) ss += xv[j].x * xv[j].x + xv[j].y * xv[j].y + xv[j].z * xv[j].z + xv[j].w * xv[j].w;
            ss = wave_sum(ss); const float rinv = rsqrtf(ss * (1.f / 1024.f) + EPSN);
            LAS const float* shift = shiftL + mb * 1024; LAS const float* scale = scaleL + mb * 1024;
            float acc[8];
#pragma unroll
            for (int i = 0; i < 8; ++i) acc[i] = 0.f;
#pragma unroll
            for (int j = 0; j < 4; ++j) {
                const int e = j * 256 + lane * 4; const f32x4 g4 = *(LAS const f32x4*)(gnl + e), s4 = *(LAS const f32x4*)(scale + e), h4 = *(LAS const f32x4*)(shift + e);
                float hv[4];
                hv[0] = xv[j].x * rinv * g4[0] * (1.f + s4[0]) + h4[0]; hv[1] = xv[j].y * rinv * g4[1] * (1.f + s4[1]) + h4[1];
                hv[2] = xv[j].z * rinv * g4[2] * (1.f + s4[2]) + h4[2]; hv[3] = xv[j].w * rinv * g4[3] * (1.f + s4[3]) + h4[3];
                u32x2 pk; pk.x = pk2(hv[0], hv[1]); pk.y = pk2(hv[2], hv[3]);
                *(u32x2*)(hb + (size_t)row * 1024 + e) = pk;
#pragma unroll
                for (int i = 0; i < 8; ++i) { const f32x4 w = *(LAS f32x4*)(wdt + i * 1024 + e); acc[i] += hv[0] * w[0] + hv[1] * w[1] + hv[2] * w[2] + hv[3] * w[3]; }
            }
            {
                const bool b5 = lane & 32, b4 = lane & 16, b3 = lane & 8;
                float t4[4], t2[2];
#pragma unroll
                for (int i = 0; i < 4; ++i) { const float keep = b5 ? acc[i + 4] : acc[i], send = b5 ? acc[i] : acc[i + 4]; t4[i] = keep + __shfl_xor(send, 32); }
#pragma unroll
                for (int i = 0; i < 2; ++i) { const float keep = b4 ? t4[i + 2] : t4[i], send = b4 ? t4[i] : t4[i + 2]; t2[i] = keep + __shfl_xor(send, 16); }
                float v = (b3 ? t2[1] : t2[0]) + __shfl_xor(b3 ? t2[0] : t2[1], 8);
                v += __shfl_xor(v, 4); v += __shfl_xor(v, 2); v += __shfl_xor(v, 1);
                if ((lane & 7) == 0) dtr[(size_t)row * 8 + ((lane >> 5) & 1) * 4 + ((lane >> 4) & 1) * 2 + ((lane >> 3) & 1)] = v;
            }
        }
}
__device__ __forceinline__ void phase_rows(const Args& a, LAS unsigned char* lds, int lpost, int lnorm) {
    LAS float* wdt = (LAS float*)lds;
    const int tid = ltid(), lane = tid & 63, wave = __builtin_amdgcn_readfirstlane(tid >> 6);
    const float* mod = (const float*)(a.ws + WS_MOD);
    const bf16_t* outp = (const bf16_t*)(a.ws + WS_U);
    float* xctx = (float*)(a.ws + WS_XCTX);
    bf16_t* hb = (bf16_t*)(a.ws + WS_H);
    float* dtr = (float*)(a.ws + WS_DTR);
    if (lnorm >= 0) for (int i = tid; i < 8192; i += 512) wdt[(i & 7) * 1024 + (i >> 3)] = a.w_in[((size_t)lnorm * 1024 + (i >> 3)) * INW + 4096 + (i & 7)];
    LAS float* gpl = (LAS float*)(lds + 32768); LAS float* gnl = gpl + 1024; LAS float* gateL = gnl + 1024; LAS float* shiftL = gateL + 9 * 1024; LAS float* scaleL = shiftL + 9 * 1024;
    for (int i = tid; i < 1024; i += 512) { gpl[i] = lpost >= 0 ? a.g_post[lpost * 1024 + i] : 0.f; gnl[i] = lnorm >= 0 ? a.g_pre[lnorm * 1024 + i] : 0.f; }
    for (int i = tid; i < 9 * 1024; i += 512) {
        const int r = i >> 10, e = i & 1023;
        gateL[i] = lpost >= 0 ? mod[(lpost * 9 + r) * 3072 + 2048 + e] : 0.f;
        shiftL[i] = lnorm >= 0 ? mod[(lnorm * 9 + r) * 3072 + e] : 0.f; scaleL[i] = lnorm >= 0 ? mod[(lnorm * 9 + r) * 3072 + 1024 + e] : 0.f;
    }
    __syncthreads();
    RowCtx c; c.a = &a; c.wdt = wdt; c.gpl = gpl; c.gnl = gnl; c.gateL = gateL; c.shiftL = shiftL; c.scaleL = scaleL; c.xctx = xctx; c.hb = hb; c.dtr = dtr; c.outp = outp;
    c.xlat = lpost <= 0 ? a.x : (const float*)a.out; c.xcx = lpost <= 0 ? a.ctx : (const float*)xctx; c.lpost = lpost; c.lnorm = lnorm; c.lane = lane;
    const int rs = gridDim.x * 8, row0 = blockIdx.x * 8 + wave;
    const int rend = (lpost == DEPTH - 1) ? TL : TT;
    float4 xa[4], xb[4], xc[4]; u32x2 oa[4], ob[4], oc[4];
#define ROW_OK(r) ((r) < rend ? (r) : row0)
    if (row0 < rend) {
        rows_load(c, row0, xa, oa); rows_load(c, ROW_OK(row0 + rs), xb, ob);
#pragma unroll 1
        for (int row = row0; row < rend; row += 3 * rs) {
            rows_load(c, ROW_OK(row + 2 * rs), xc, oc); rows_compute(c, row, xa, oa);
            if (row + rs < rend) { rows_load(c, ROW_OK(row + 3 * rs), xa, oa); rows_compute(c, row + rs, xb, ob); }
            if (row + 2 * rs < rend) { rows_load(c, ROW_OK(row + 4 * rs), xb, ob); rows_compute(c, row + 2 * rs, xc, oc); }
        }
    }
#undef ROW_OK
}

__device__ __forceinline__ void seq_nb(int t, bool& hasp, bool& hasn) {
    int pos, len; if (t < TL) { pos = t & (SEQ - 1); len = SEQ; } else { pos = (t - TL) & (CTXL - 1); len = CTXL; }
    hasp = pos > 0; hasn = pos < len - 1;
}
__device__ __forceinline__ void ssd_conv8(const bf16_t* __restrict__ u, const float* __restrict__ cw, const float* __restrict__ cb, int t, int ch0, bool hasp, bool hasn, float (&o)[8]) {
    const bf16_t* p = u + (size_t)t * ULD + U_XBC + ch0;
    float v0[8], v1[8], v2[8];
    const u32x4 z = {0u, 0u, 0u, 0u};
    unpack8(hasp ? *(const u32x4*)(p - ULD) : z, v0); unpack8(*(const u32x4*)p, v1); unpack8(hasn ? *(const u32x4*)(p + ULD) : z, v2);
#pragma unroll
    for (int i = 0; i < 8; ++i) { const float s = cw[ch0 + i] * v0[i] + cw[768 + ch0 + i] * v1[i] + cw[1536 + ch0 + i] * v2[i] + cb[ch0 + i]; o[i] = silu_f(s); }
}
__device__ __forceinline__ void phase_prep(const Args& a, LAS unsigned char* lds, int layer) {
    typedef float f32x2 __attribute__((ext_vector_type(2)));
    LAS f32x2* tab = (LAS f32x2*)lds;
    const int tid = ltid();
    const bf16_t* __restrict__ u = (const bf16_t*)(a.ws + WS_U);
    bf16_t* __restrict__ ymix = (bf16_t*)(a.ws + WS_H);
    bf16_t* __restrict__ xbc = (bf16_t*)(a.ws + WS_XBC);
    for (int i = tid; i < 2048; i += 512) {
        const int pos = i >> 5, f = i & 31;
        const float inv = exp2f(-(float)f * 0.41524101186092029f);
        const float ang = (float)pos * inv;
        const float n = rintf(ang * 0.15915494309189535f);
        float rr = fmaf(-n, 6.28125f, ang); rr = fmaf(-n, 0.0019353071795864769f, rr);
        f32x2 cs; cs.x = __cosf(rr); cs.y = __sinf(rr); tab[i] = cs;
    }
    __syncthreads();
    const int gstride = gridDim.x * 512, g0 = blockIdx.x * 512 + tid;
    const float* caw = a.conv_a_w + layer * 768;
#pragma unroll 2
    for (int it = g0; it < TT * 32; it += gstride) {
        const int t = it >> 5, ch0 = (it & 31) * 8; bool hasp, hasn; seq_nb(t, hasp, hasn);
        const bf16_t* p = u + (size_t)t * ULD + ch0; const u32x4 z = {0u, 0u, 0u, 0u};
        float i0[8], i1[8], i2[8], c0[8], c1[8], c2[8], bb[8], zz[8], o[8];
        unpack8(hasp ? *(const u32x4*)(p + U_SCIN - ULD) : z, i0); unpack8(*(const u32x4*)(p + U_SCIN), i1); unpack8(hasn ? *(const u32x4*)(p + U_SCIN + ULD) : z, i2);
        unpack8(hasp ? *(const u32x4*)(p + U_SCC - ULD) : z, c0); unpack8(*(const u32x4*)(p + U_SCC), c1); unpack8(hasn ? *(const u32x4*)(p + U_SCC + ULD) : z, c2);
        unpack8(*(const u32x4*)(p + U_SCB), bb); unpack8(*(const u32x4*)(p + U_SCZ), zz);
#pragma unroll
        for (int i = 0; i < 8; ++i) {
            const float cv = caw[ch0 + i] * (c0[i] * i0[i]) + caw[256 + ch0 + i] * (c1[i] * i1[i]) + caw[512 + ch0 + i] * (c2[i] * i2[i]);
            o[i] = bb[i] * cv * silu_f(zz[i]);
        }
        *(u32x4*)(ymix + (size_t)t * 1024 + ch0) = __builtin_bit_cast(u32x4, pack8(o));
    }
    const float* cw = a.ssd_conv_w + layer * 3 * 768; const float* cb = a.ssd_conv_b + layer * 768;
#pragma unroll 4
    for (int it = g0; it < TT * 32; it += gstride) {
        const int t = it >> 5, ch0 = (it & 31) * 8; bool hasp, hasn; seq_nb(t, hasp, hasn);
        float o[8]; ssd_conv8(u, cw, cb, t, ch0, hasp, hasn, o);
        *(u32x4*)(xbc + (size_t)t * 768 + ch0) = __builtin_bit_cast(u32x4, pack8(o));
    }
#pragma unroll 2
    for (int it = g0; it < TT * 32; it += gstride) {
        const int t = it >> 5, ru = it & 31, blk = ru >> 2, sub = ru & 3; bool hasp, hasn; seq_nb(t, hasp, hasn);
        const int chA = 256 + blk * 64 + sub * 8, chB = chA + 32;
        float t1[8], t2[8]; ssd_conv8(u, cw, cb, t, chA, hasp, hasn, t1); ssd_conv8(u, cw, cb, t, chB, hasp, hasn, t2);
        if (t < TL) {
            const int l = t & (SEQ - 1); const int pos = (blk & 1) ? (l & 63) : (l >> 6);
#pragma unroll
            for (int i = 0; i < 8; ++i) { const f32x2 cs = tab[pos * 32 + sub * 8 + i]; const float x1 = t1[i], x2 = t2[i]; t1[i] = x1 * cs.x - x2 * cs.y; t2[i] = x1 * cs.y + x2 * cs.x; }
        }
        *(u32x4*)(xbc + (size_t)t * 768 + chA) = __builtin_bit_cast(u32x4, pack8(t1));
        *(u32x4*)(xbc + (size_t)t * 768 + chB) = __builtin_bit_cast(u32x4, pack8(t2));
    }
    {
        LAS bf16_t* tile = (LAS bf16_t*)(lds + 16384);
        bf16_t* vt = (bf16_t*)(a.ws + WS_VT);
#define VT_SRC(TI, ROW0, HH) do { if ((TI) < 4096) { ROW0 = ((TI) >> 9) * SEQ + ((TI) & 63) * 64; HH = ((TI) >> 6) & 7; } else { const int tj_ = (TI) - 4096; ROW0 = TL + (tj_ >> 5) * CTXL + (tj_ & 3) * 64; HH = (tj_ >> 2) & 7; } } while (0)
        const int tok = tid >> 3, seg = tid & 7;
        int ti = blockIdx.x;
        u32x4 v = {0u, 0u, 0u, 0u};
        if (ti < 4096 + 256) { int r0_, h_; VT_SRC(ti, r0_, h_); v = *(const u32x4*)(u + (size_t)(r0_ + tok) * ULD + U_V + h_ * 64 + seg * 8); }
        for (; ti < 4096 + 256; ti += gridDim.x) {
            const int tn = ti + (int)gridDim.x < 4096 + 256 ? ti + (int)gridDim.x : ti;
            int rn_, hn_; VT_SRC(tn, rn_, hn_);
            const u32x4 vn = *(const u32x4*)(u + (size_t)(rn_ + tok) * ULD + U_V + hn_ * 64 + seg * 8);
            int b, h; size_t obase; const int ostride = 32;
            if (ti < 4096) { b = ti >> 9; h = (ti >> 6) & 7; const int tb = ti & 63; obase = (size_t)(b * 8 + h) * 64 * VLD + (size_t)tb * 4096; }
            else { const int tj = ti - 4096; b = tj >> 5; h = (tj >> 2) & 7; const int tb = tj & 3; obase = VT_CTX + (size_t)(b * 8 + h) * 64 * CTXL + (size_t)tb * 4096; }
            tile[(seg * 8 + 0) * 72 + tok] = (bf16_t)(v.x & 0xffffu); tile[(seg * 8 + 1) * 72 + tok] = (bf16_t)(v.x >> 16);
            tile[(seg * 8 + 2) * 72 + tok] = (bf16_t)(v.y & 0xffffu); tile[(seg * 8 + 3) * 72 + tok] = (bf16_t)(v.y >> 16);
            tile[(seg * 8 + 4) * 72 + tok] = (bf16_t)(v.z & 0xffffu); tile[(seg * 8 + 5) * 72 + tok] = (bf16_t)(v.z >> 16);
            tile[(seg * 8 + 6) * 72 + tok] = (bf16_t)(v.w & 0xffffu); tile[(seg * 8 + 7) * 72 + tok] = (bf16_t)(v.w >> 16);
            __syncthreads();
            const int d = tid >> 3, ts = (tid & 7) * 8;
            *(u32x4*)(vt + obase + (size_t)(ts >> 5) * 2048 + (size_t)d * ostride + (ts & 31)) = *(LAS u32x4*)(tile + d * 72 + ts);
            __syncthreads();
            v = vn;
        }
#undef VT_SRC
    }
    const float* dtr = (const float*)(a.ws + WS_DTR); float* dts = (float*)(a.ws + WS_DTS);
    for (int it = g0; it < TT * 8; it += gstride) {
        const int j = it & 7; const float bias = j < 4 ? a.dt_bias_f[layer * 4 + j] : a.dt_bias_b[layer * 4 + j - 4];
        dts[it] = softplus_f(dtr[it] + bias);
    }
}

__device__ __forceinline__ void phase_s1(const Args& a, LAS unsigned char* lds, int layer) {
    LAS bf16_t* xs = (LAS bf16_t*)lds;
    LAS bf16_t* bs = xs + 128 * XS_LD;
    LAS float* wl = (LAS float*)(lds + 2 * 128 * XS_LD * 2);
    const int tid = ltid(), lane = tid & 63, wave = __builtin_amdgcn_readfirstlane(tid >> 6), r16 = lane & 15, quad = lane >> 4;
    const bf16_t* xbc = (const bf16_t*)(a.ws + WS_XBC);
    const float* dts = (const float*)(a.ws + WS_DTS); float* acs = (float*)(a.ws + WS_ACS); float* cdec = (float*)(a.ws + WS_CDEC); bf16_t* st = (bf16_t*)(a.ws + WS_ST);
    const int h = wave >> 1, dir = wave & 1, g = h >> 1;
    const float a_h = -__expf(dir ? a.a_log_b[layer * 4 + h] : a.a_log_f[layer * 4 + h]);
    for (int unit = blockIdx.x; unit < NB * NCH; unit += gridDim.x) {
        const int b = unit / NCH, c = unit % NCH, row0 = chunk_row0(b, c);
        {
            const int i0 = dir ? 127 - 2 * lane : 2 * lane, i1 = dir ? 126 - 2 * lane : 2 * lane + 1;
            const float d0 = dts[(size_t)(row0 + i0) * 8 + dir * 4 + h], d1 = dts[(size_t)(row0 + i1) * 8 + dir * 4 + h];
            const float v0 = d0 * a_h, v1 = d1 * a_h, tot = v0 + v1; float incl = tot;
#pragma unroll
            for (int o = 1; o < 64; o <<= 1) { const float tv = __shfl_up(incl, o); if (lane >= o) incl += tv; }
            const float excl = incl - tot, c0 = excl + v0, c1 = excl + tot, total = __shfl(incl, 63);
            acs[(size_t)(row0 + i0) * 8 + dir * 4 + h] = c0; acs[(size_t)(row0 + i1) * 8 + dir * 4 + h] = c1;
            wl[wave * 128 + i0] = __expf(total - c0) * d0; wl[wave * 128 + i1] = __expf(total - c1) * d1;
            if (lane == 0) cdec[((b * NCH + c) * 4 + h) * 2 + dir] = __expf(total);
        }
        for (int i = tid; i < 8192; i += 512) {
            const int j = i >> 6, seg = i & 63; const u32x4 v = *(const u32x4*)(xbc + (size_t)(row0 + j) * 768 + seg * 8);
            if (seg < 32) *(LAS u32x4*)(xs + j * XS_LD + seg * 8) = v; else *(LAS u32x4*)(bs + j * XS_LD + (seg - 32) * 8) = v;
        }
        __syncthreads();
        bf16x8 A[4][4];
#pragma unroll
        for (int pt = 0; pt < 4; ++pt)
#pragma unroll
            for (int js = 0; js < 4; ++js) {
                const int trow = js * 32 + quad * 8 + (r16 >> 2), tcol = h * 64 + pt * 16 + (r16 & 3) * 4;
                const s16x4 x0 = __builtin_amdgcn_ds_read_tr16_b64_v4i16((LAS s16x4*)(xs + trow * XS_LD + tcol));
                const s16x4 x1 = __builtin_amdgcn_ds_read_tr16_b64_v4i16((LAS s16x4*)(xs + (trow + 4) * XS_LD + tcol));
                const f32x4 w0 = *(LAS const f32x4*)(wl + wave * 128 + js * 32 + quad * 8), w1 = *(LAS const f32x4*)(wl + wave * 128 + js * 32 + quad * 8 + 4);
                float f[8];
#pragma unroll
                for (int e = 0; e < 4; ++e) { f[e] = bf2f((bf16_t)x0[e]) * w0[e]; f[4 + e] = bf2f((bf16_t)x1[e]) * w1[e]; }
                A[pt][js] = pack8(f);
            }
        bf16_t* stp = st + (size_t)(((b * NCH + c) * 4 + h) * 2 + dir) * 8192;
#pragma unroll 1
        for (int nt = 0; nt < 8; ++nt) {
            f32x4 acc[4];
#pragma unroll
            for (int pt = 0; pt < 4; ++pt) acc[pt] = (f32x4){0.f, 0.f, 0.f, 0.f};
#pragma unroll
            for (int js = 0; js < 4; ++js) {
                const int trow = js * 32 + quad * 8 + (r16 >> 2), tcol = g * 128 + nt * 16 + (r16 & 3) * 4;
                const s16x4 b0 = __builtin_amdgcn_ds_read_tr16_b64_v4i16((LAS s16x4*)(bs + trow * XS_LD + tcol));
                const s16x4 b1 = __builtin_amdgcn_ds_read_tr16_b64_v4i16((LAS s16x4*)(bs + (trow + 4) * XS_LD + tcol));
                const bf16x8 bv = __builtin_shufflevector(b0, b1, 0, 1, 2, 3, 4, 5, 6, 7);
#pragma unroll
                for (int pt = 0; pt < 4; ++pt) acc[pt] = mfma16(bv, A[pt][js], acc[pt]);
            }
#pragma unroll
            for (int pt = 0; pt < 4; ++pt) { u32x2 w; w.x = pk2(acc[pt][0], acc[pt][1]); w.y = pk2(acc[pt][2], acc[pt][3]); *(u32x2*)(stp + (pt * 16 + r16) * 128 + nt * 16 + quad * 4) = w; }
        }
        __syncthreads();
    }
}

__device__ __forceinline__ void phase_scan(const Args& a) {
    bf16_t* st = (bf16_t*)(a.ws + WS_ST); const float* cdec = (const float*)(a.ws + WS_CDEC);
    const int tid_ = ltid();
    for (int it = blockIdx.x * 512 + tid_; it < 64 * 2048; it += gridDim.x * 512) {
        const int bhd = it >> 11, e4 = it & 2047, b = bhd >> 3, h = (bhd >> 1) & 3, dir = bhd & 1;
        float s0 = 0.f, s1 = 0.f, s2 = 0.f, s3 = 0.f;
        int sidx = ((b * NCH + (dir ? 1 : 0)) * 4 + h) * 2 + dir;
        u32x2 vn = *(const u32x2*)(st + (size_t)sidx * 8192 + e4 * 4); float dn = cdec[sidx];
#pragma unroll 2
        for (int step = 0; step < NCH; ++step) {
            u32x2* p = (u32x2*)(st + (size_t)sidx * 8192 + e4 * 4);
            const u32x2 v = vn; const float dec = dn;
            if (step + 1 < NCH) {
                const int c2 = dir ? (step + 1 < 2 ? 1 - (step + 1) : 35 - (step + 1)) : step + 1;
                sidx = ((b * NCH + c2) * 4 + h) * 2 + dir;
                vn = *(const u32x2*)(st + (size_t)sidx * 8192 + e4 * 4); dn = cdec[sidx];
            }
            u32x2 o; o.x = pk2(s0, s1); o.y = pk2(s2, s3); *p = o;
            s0 = s0 * dec + bf_lo(v.x); s1 = s1 * dec + bf_hi(v.x); s2 = s2 * dec + bf_lo(v.y); s3 = s3 * dec + bf_hi(v.y);
        }
    }
}

struct KVFrag { bf16x8 k[4]; bf16x8 v[4]; };
__device__ __forceinline__ void kv_load(KVFrag& f, const bf16_t* kp, const bf16_t* vp, int vstride16) {
    f.k[0] = ldg8(kp); f.k[1] = ldg8(kp + 512); f.k[2] = ldg8(kp + 1024); f.k[3] = ldg8(kp + 1536);
#pragma unroll
    for (int db = 0; db < 4; ++db) f.v[db] = ldg8(vp + (size_t)db * vstride16);
}
__device__ __forceinline__ void attn_block(const KVFrag& f, LAS const bf16_t* ql, float (&m)[2], float (&l)[2], f32x4 (&O)[2][4], LAS const float* rprow, bool isw, int half32, const int (&cib0)[2], const int (&d0)[2], int skipmask) {
#pragma unroll
    for (int jl = 0; jl < 2; ++jl) {
        if ((skipmask >> (jl * 2 + (half32 >> 5))) & 1) continue;
        f32x4 s0 = {0.f, 0.f, 0.f, 0.f}, s1 = {0.f, 0.f, 0.f, 0.f};
        LAS const bf16_t* qv = ql + jl * 16 * 72; asm volatile("" : "+v"(qv));
        const bf16x8 q0 = *(LAS const bf16x8*)qv, q1 = *(LAS const bf16x8*)(qv + 32);
        s0 = mfma16(f.k[0], q0, s0); s0 = mfma16(f.k[1], q1, s0);
        s1 = mfma16(f.k[2], q0, s1); s1 = mfma16(f.k[3], q1, s1);
        float sv[8];
        if (isw) {
            LAS const float* bp = rprow + (cib0[jl] + half32); const int d = d0[jl] + half32;
#pragma unroll
            for (int e = 0; e < 8; ++e) sv[e] = bp[e];
#pragma unroll
            for (int e = 0; e < 8; ++e) { const float sc = (e < 4 ? s0[e & 3] : s1[e & 3]); const float t = fmaf(sc, 0.18033688011112042f, sv[e]); sv[e] = ((unsigned)(d + e) < 16u) ? t : -1e30f; }
        } else {
#pragma unroll
            for (int e = 0; e < 4; ++e) { sv[e] = s0[e] * 0.18033688011112042f; sv[4 + e] = s1[e] * 0.18033688011112042f; }
        }
        float bm = fmaxf(fmaxf(fmaxf(sv[0], sv[1]), fmaxf(sv[2], sv[3])), fmaxf(fmaxf(sv[4], sv[5]), fmaxf(sv[6], sv[7])));
        bm = fmaxf(bm, __shfl_xor(bm, 16)); bm = fmaxf(bm, __shfl_xor(bm, 32));
        if (__builtin_amdgcn_ballot_w64(bm > m[jl]) != 0ull) {
            const float mn = fmaxf(m[jl], bm), alpha = __builtin_amdgcn_exp2f(m[jl] - mn);
            m[jl] = mn; l[jl] *= alpha;
#pragma unroll
            for (int db = 0; db < 4; ++db) O[jl][db] *= alpha;
        }
        const float mc = m[jl];
        float ps = 0.f;
#pragma unroll
        for (int e = 0; e < 8; ++e) { sv[e] = __builtin_amdgcn_exp2f(sv[e] - mc); ps += sv[e]; }
        l[jl] += ps;
        const bf16x8 pb = pack8(sv);
#pragma unroll
        for (int db = 0; db < 4; ++db) O[jl][db] = mfma16(f.v[db], pb, O[jl][db]);
    }
}
template <bool WIN>
__device__ __forceinline__ void attn_row(const Args& a, int b, int r, int jp, int h, int lane, LAS const float* rpl, LAS bf16_t* qls) {
    const bf16_t* u = (const bf16_t*)(a.ws + WS_U); bf16_t* ymix = (bf16_t*)(a.ws + WS_H); const bf16_t* vt = (const bf16_t*)(a.ws + WS_VT);
    const int r16 = lane & 15, quad = lane >> 4;
    const int qrow0 = WIN ? b * SEQ + r * 64 + jp * 32 : TL + b * CTXL + r * 32;
    const int r0 = WIN ? min(max(r - 4, 0), 56) : 0;
#pragma unroll
    for (int t = 0; t < 4; ++t) { const int i = lane + 64 * t, row = i >> 3, seg = i & 7; *(LAS bf16x8*)(qls + row * 72 + seg * 8) = ldg8(u + (size_t)(qrow0 + row) * ULD + U_Q + h * 64 + seg * 8); }
    LAS const bf16_t* ql = qls + r16 * 72 + quad * 8;
    float m[2], l[2]; f32x4 O[2][4];
#pragma unroll
    for (int jl = 0; jl < 2; ++jl) { m[jl] = -1e30f; l[jl] = 0.f;
#pragma unroll
        for (int db = 0; db < 4; ++db) O[jl][db] = (f32x4){0.f, 0.f, 0.f, 0.f}; }
    const bf16_t* kbp = (const bf16_t*)(a.ws + WS_KB);
    const bf16_t* kctx = kbp + KB_CTX + (size_t)(b * 8 + h) * 8 * 2048 + r16 * 32 + quad * 8;
    const bf16_t* vctx = vt + VT_CTX + (size_t)(b * 8 + h) * 64 * CTXL + r16 * 32 + quad * 8;
    const bf16_t* kwin = kbp + ((size_t)(b * 8 + h) * 128 + r0 * 2) * 2048 + r16 * 32 + quad * 8;
    const bf16_t* vwin = vt + (size_t)(b * 8 + h) * 64 * VLD + (size_t)(r0 * 2) * 2048 + r16 * 32 + quad * 8;
    constexpr int NPAIR = WIN ? 12 : 4;
    int cib0[2], d0[2];
#pragma unroll
    for (int jl = 0; jl < 2; ++jl) { const int cq = jp * 32 + jl * 16 + r16, c0 = min(max(cq - 8, 0), 48); cib0[jl] = quad * 8 - cq + 15; d0[jl] = quad * 8 - c0; }
    const int skipm = jp == 0 ? 2 : 4;
    KVFrag fa, fb;
    kv_load(fa, kctx, vctx, 512); kv_load(fb, kctx + 2048, vctx + 2048, 512);
#pragma unroll 1
    for (int pr = 0; pr < NPAIR; ++pr) {
        const int nx = pr + 1 < NPAIR ? pr + 1 : pr;
        const bool nctx = nx < 4;
        const bf16_t* nk = nctx ? kctx + (size_t)nx * 4096 : kwin + (size_t)(nx - 4) * 4096;
        const bf16_t* nv = nctx ? vctx + (size_t)nx * 4096 : vwin + (size_t)(nx - 4) * 4096;
        const int nstr = 512;
        const bool isw = WIN && pr >= 4;
        LAS const float* rprow = rpl + (isw ? (r0 + (pr - 4) - r + 7) : 15) * 32;
        attn_block(fa, ql, m, l, O, rprow, isw, 0, cib0, d0, isw ? skipm : 0);
        kv_load(fa, nk, nv, nstr);
        attn_block(fb, ql, m, l, O, rprow, isw, 32, cib0, d0, isw ? skipm : 0);
        kv_load(fb, nk + 2048, nv + 2048, nstr);
    }
#pragma unroll
    for (int jl = 0; jl < 2; ++jl) {
        float lt = l[jl]; lt += __shfl_xor(lt, 16); lt += __shfl_xor(lt, 32);
        const float inv = 1.f / lt;
        const size_t orow = (size_t)(qrow0 + jl * 16 + r16);
#pragma unroll
        for (int db = 0; db < 4; ++db) {
            const int ch = h * 64 + db * 16 + quad * 4;
            const u32x2 zz = *(const u32x2*)(u + orow * ULD + U_NAZ + ch);
            const float y0 = O[jl][db][0] * inv * silu_f(bf_lo(zz.x)), y1 = O[jl][db][1] * inv * silu_f(bf_hi(zz.x)), y2 = O[jl][db][2] * inv * silu_f(bf_lo(zz.y)), y3 = O[jl][db][3] * inv * silu_f(bf_hi(zz.y));
            u32x2 o; o.x = pk2(y0, y1); o.y = pk2(y2, y3);
            *(u32x2*)(ymix + orow * 1024 + 256 + ch) = o;
        }
    }
}
template <int G>
__device__ __forceinline__ void s3_group(const Args& a, int layer, LAS u32x2* Y, f32x4& ssv, LAS const bf16_t* xs, LAS const float* arr, const bf16_t* u, const bf16_t* xbc, const bf16_t* st,
                                         int b, int c, int row0, int wave, int r16, int quad) {
    const int iop = wave * 16 + r16;
    bf16x8 cf[4];
#pragma unroll
    for (int ks = 0; ks < 4; ++ks) cf[ks] = ldg8(xbc + (size_t)(row0 + iop) * 768 + 512 + G * 128 + ks * 32 + quad * 8);
    f32x4 accd[2][4];
#pragma unroll
    for (int hh = 0; hh < 2; ++hh)
#pragma unroll
        for (int pt = 0; pt < 4; ++pt) accd[hh][pt] = (f32x4){0.f, 0.f, 0.f, 0.f};
    LAS const float* dtf0 = arr + (0 * 4 + G * 2) * 128; LAS const float* dtb0 = arr + (1 * 4 + G * 2) * 128;
    LAS const float* af0 = arr + (2 * 4 + G * 2) * 128; LAS const float* ab0 = arr + (3 * 4 + G * 2) * 128;
#pragma unroll 1
    for (int jb = 0; jb < 4; ++jb) {
        f32x4 GT2[2];
#pragma unroll
        for (int t2 = 0; t2 < 2; ++t2) {
            f32x4 acc = {0.f, 0.f, 0.f, 0.f};
            const bf16_t* bp = xbc + (size_t)(row0 + (2 * jb + t2) * 16 + r16) * 768 + 256 + G * 128 + quad * 8;
#pragma unroll
            for (int ks = 0; ks < 4; ++ks) acc = mfma16(ldg8(bp + ks * 32), cf[ks], acc);
            GT2[t2] = acc;
        }
#pragma unroll
        for (int hh = 0; hh < 2; ++hh) {
            LAS const float* dtf = dtf0 + hh * 128; LAS const float* dtb = dtb0 + hh * 128; LAS const float* af = af0 + hh * 128; LAS const float* ab = ab0 + hh * 128;
            const float aif = af[iop], aib = ab[iop];
            float f[8];
#pragma unroll
            for (int s = 0; s < 8; ++s) {
                const int j = (2 * jb + (s >> 2)) * 16 + quad * 4 + (s & 3);
                const bool fw = j < iop;
                const float e = fw ? aif - af[j] : aib - ab[j];
                float m = (fw ? dtf[j] : dtb[j]) * __expf(fminf(e, 0.f));
                if (j == iop) m = dtf[j] + dtb[j];
                f[s] = GT2[s >> 2][s & 3] * m;
            }
            const bf16x8 aop = pack8(f);
#pragma unroll
            for (int pt = 0; pt < 4; ++pt) {
                const int trow = (2 * jb) * 16 + quad * 4 + (r16 >> 2), tcol = (G * 2 + hh) * 64 + pt * 16 + (r16 & 3) * 4;
                const s16x4 b0 = __builtin_amdgcn_ds_read_tr16_b64_v4i16((LAS s16x4*)(LAS bf16_t*)(xs + trow * XS_LD + tcol));
                const s16x4 b1 = __builtin_amdgcn_ds_read_tr16_b64_v4i16((LAS s16x4*)(LAS bf16_t*)(xs + (trow + 16) * XS_LD + tcol));
                const bf16x8 bop = __builtin_shufflevector(b0, b1, 0, 1, 2, 3, 4, 5, 6, 7);
                accd[hh][pt] = mfma16(aop, bop, accd[hh][pt]);
            }
            asm volatile("" ::: "memory");
        }
    }
#pragma unroll
    for (int hh = 0; hh < 2; ++hh) {
        const int h = G * 2 + hh;
#pragma unroll
        for (int dir = 0; dir < 2; ++dir) {
            const bf16_t* pp = st + (size_t)(((b * NCH + c) * 4 + h) * 2 + dir) * 8192;
            const float ei = __expf(arr[((2 + dir) * 4 + h) * 128 + iop]);
#pragma unroll
            for (int ks = 0; ks < 4; ++ks) {
                float cfv[8]; unpack8(__builtin_bit_cast(u32x4, cf[ks]), cfv);
#pragma unroll
                for (int s = 0; s < 8; ++s) cfv[s] *= ei;
                const bf16x8 aop = pack8(cfv);
#pragma unroll
                for (int pt = 0; pt < 4; ++pt) {
                    accd[hh][pt] = mfma16(aop, ldg8(pp + (pt * 16 + r16) * 128 + ks * 32 + quad * 8), accd[hh][pt]);
                }
            }
            asm volatile("" ::: "memory");
        }
        const float dh = a.ssd_d[layer * 4 + h];
#pragma unroll
        for (int pt = 0; pt < 4; ++pt) {
            f32x4 yv;
#pragma unroll
            for (int jj = 0; jj < 4; ++jj) {
                const int io = wave * 16 + quad * 4 + jj, ch = h * 64 + pt * 16 + r16;
                const float y = accd[hh][pt][jj] + dh * bf2f(xs[io * XS_LD + ch]);
                const float z = bf2f(u[(size_t)(row0 + io) * ULD + U_SSZ + ch]);
                yv[jj] = y * silu_f(z);
            }
            ssv += yv * yv;
            u32x2 pk; pk.x = pk2(yv[0], yv[1]); pk.y = pk2(yv[2], yv[3]);
            Y[(h * 4 + pt) * 64] = pk;
        }
    }
}
__device__ __forceinline__ void s3_unit(const Args& a, LAS unsigned char* lds, int layer, int b, int c) {
    LAS bf16_t* xs = (LAS bf16_t*)lds;
    LAS float* arr = (LAS float*)(lds + 128 * XS_LD * 2);
    const int tid = ltid(), lane = tid & 63, wave = __builtin_amdgcn_readfirstlane(tid >> 6), r16 = lane & 15, quad = lane >> 4;
    const bf16_t* u = (const bf16_t*)(a.ws + WS_U); bf16_t* ymix = (bf16_t*)(a.ws + WS_H);
    const bf16_t* xbc = (const bf16_t*)(a.ws + WS_XBC);
    const float* dts = (const float*)(a.ws + WS_DTS); const float* acs = (const float*)(a.ws + WS_ACS); const bf16_t* st = (const bf16_t*)(a.ws + WS_ST);
    {
        const int row0 = chunk_row0(b, c);
        for (int i = tid; i < 4096; i += 512) { const int j = i >> 5, seg = i & 31; *(LAS u32x4*)(xs + j * XS_LD + seg * 8) = *(const u32x4*)(xbc + (size_t)(row0 + j) * 768 + seg * 8); }
        for (int i = tid; i < 1024; i += 512) {
            const int j = i >> 3, col = i & 7;
            arr[((col < 4 ? 0 : 1) * 4 + (col & 3)) * 128 + j] = dts[(size_t)(row0 + j) * 8 + col];
            arr[((col < 4 ? 2 : 3) * 4 + (col & 3)) * 128 + j] = acs[(size_t)(row0 + j) * 8 + col];
        }
        __syncthreads();
        LAS u32x2* Y = (LAS u32x2*)(lds + 128 * XS_LD * 2 + 8192) + wave * 1024 + lane;
        f32x4 ssv = {0.f, 0.f, 0.f, 0.f};
        s3_group<0>(a, layer, Y, ssv, xs, arr, u, xbc, st, b, c, row0, wave, r16, quad);
        s3_group<1>(a, layer, Y, ssv, xs, arr, u, xbc, st, b, c, row0, wave, r16, quad);
        f32x4 rinv;
#pragma unroll
        for (int jj = 0; jj < 4; ++jj) {
            float ss = ssv[jj];
            ss += __shfl_xor(ss, 1); ss += __shfl_xor(ss, 2); ss += __shfl_xor(ss, 4); ss += __shfl_xor(ss, 8);
            rinv[jj] = rsqrtf(ss * (1.f / 256.f) + EPSN);
        }
        const float* nw = a.ssd_norm_w + layer * 256;
#pragma unroll
        for (int h = 0; h < 4; ++h)
#pragma unroll
            for (int pt = 0; pt < 4; ++pt) {
                const int ch = h * 64 + pt * 16 + r16; const float w = nw[ch]; const u32x2 yq = Y[(h * 4 + pt) * 64];
#pragma unroll
                for (int jj = 0; jj < 4; ++jj) {
                    const int io = wave * 16 + quad * 4 + jj; const unsigned pw = (jj < 2) ? yq.x : yq.y; const float yv = (jj & 1) ? bf_hi(pw) : bf_lo(pw);
                    ymix[(size_t)(row0 + io) * 1024 + 768 + ch] = f2bf(yv * rinv[jj] * w);
                }
            }
        __syncthreads();
    }
}

__device__ __forceinline__ void attn_tables(const Args& a, LAS unsigned char* lds, int layer) {
    const int tid = ltid(), lane = tid & 63, wave = __builtin_amdgcn_readfirstlane(tid >> 6);
#pragma unroll
    for (int hb = 0; hb < 2; ++hb) {
        LAS float* rpl = (LAS float*)(lds + 1024) + (wave * 2 + hb) * 512;
        const float* src = a.rpb + (size_t)(layer * 8 + (wave & 3) + 4 * hb) * 465;
        for (int i = lane; i < 512; i += 64) rpl[i] = 0.f;
        for (int i = lane; i < 465; i += 64) rpl[(i / 31) * 32 + (i % 31)] = src[i] * 1.4426950408889634f;
    }
}
__device__ __forceinline__ void attn_item(const Args& a, LAS unsigned char* lds, int layer, int b, int j) {
    const int tid = ltid(), lane = tid & 63, wave = __builtin_amdgcn_readfirstlane(tid >> 6);
    const int hb = j & 1, h = (wave & 3) + 4 * hb, jp = wave >> 2;
    LAS const float* rpl = (LAS const float*)(lds + 1024) + (wave * 2 + hb) * 512;
    LAS bf16_t* qls = (LAS bf16_t*)(lds + 1024 + 32768 + 1024) + wave * 32 * 72;
    if (j < 128) attn_row<true>(a, b, j >> 1, jp, h, lane, rpl, qls);
    else attn_row<false>(a, b, ((j - 128) >> 1) * 2 + jp, 0, h, lane, rpl, qls);
}
__device__ __forceinline__ void phase_mix(const Args& a, LAS unsigned char* lds, int layer, int rep = 0) {
    unsigned* ctr = (unsigned*)(a.ws + WS_BAR + 16384) + layer * 64 + rep * 32;
    LAS volatile int* qslot = (LAS volatile int*)(lds + LDS_BYTES - 64);
    const int tid = ltid();
    const int cfirst = (layer == DEPTH - 1) ? 2 : 0, ncu = NCH - cfirst, n_s3 = NB * ncu;
    const int nper = 128 + (layer < DEPTH - 1 ? 8 : 0), total = n_s3 + NB * nper;
    const int natt = NB * nper; (void)total;
    int nxt = 0;
    if (tid == 0) nxt = (int)__hip_atomic_fetch_add(ctr, 1u, __ATOMIC_RELAXED, __HIP_MEMORY_SCOPE_AGENT);
#pragma unroll 1
    for (;;) {
        __syncthreads();
        if (tid == 0) *qslot = nxt;
        __syncthreads();
        const int item = __builtin_amdgcn_readfirstlane(*qslot);
        if (item >= n_s3) break;
        if (tid == 0) nxt = (int)__hip_atomic_fetch_add(ctr, 1u, __ATOMIC_RELAXED, __HIP_MEMORY_SCOPE_AGENT);
        s3_unit(a, lds, layer, item / ncu, cfirst + item % ncu);
    }
    if (tid == 0) nxt = (int)__hip_atomic_fetch_add(ctr + 16, 1u, __ATOMIC_RELAXED, __HIP_MEMORY_SCOPE_AGENT);
    __syncthreads();
    attn_tables(a, lds, layer);
#pragma unroll 1
    for (;;) {
        __syncthreads();
        if (tid == 0) *qslot = nxt;
        __syncthreads();
        const int item = __builtin_amdgcn_readfirstlane(*qslot);
        if (item >= natt) break;
        if (tid == 0) nxt = (int)__hip_atomic_fetch_add(ctr + 16, 1u, __ATOMIC_RELAXED, __HIP_MEMORY_SCOPE_AGENT);
        attn_item(a, lds, layer, item / nper, item % nper);
    }
}

struct EpiU {
    static constexpr bool PERM = true, AFTER_DRAIN = false;
    bf16_t* U; bf16_t* KB;
    __device__ __forceinline__ void operator()(const pg8::f32x4 (&acc)[2][2][4][2], const pg8::Unit& un, int wr, int wc, int fr, int fq) const {
        const int pn = un.pn, pm = un.pm;
        const bool isk = (pn == 6 || pn == 7);
        const bool lat = pm < 128;
        const int b = lat ? (pm >> 4) : (pm - 128), blk0 = lat ? (pm & 15) * 8 : 0;
        const unsigned hstride = lat ? 128u * 2048u : 8u * 2048u;
        bf16_t* kbase = KB + (lat ? (size_t)0 : KB_CTX) + (size_t)(b * 8) * hstride;
#pragma unroll
        for (int ai = 0; ai < 2; ++ai)
#pragma unroll
            for (int m = 0; m < 4; ++m) {
                const int rl = ai * 128 + wr * 64 + m * 16 + fr;
                const int kin = rl & 31, o = (kin >> 2) & 1, rho = (kin >> 3) * 4 + (kin & 3);
                const unsigned koff = (unsigned)(blk0 + (rl >> 5)) * 2048u + (unsigned)((o * 2) * 16 + rho) * 32u;
                bf16_t* rowp = U + (size_t)(pm * 256 + rl) * ULD + (pn < 6 ? pn : pn - 2) * 256 + wc * 32 + 8 * fq;
#pragma unroll
                for (int bj = 0; bj < 2; ++bj) {
                    const pg8::f32x4 v0 = acc[ai][bj][m][0], v1 = acc[ai][bj][m][1];
                    u32x4 w; w.x = pk2(v0[0], v0[1]); w.y = pk2(v0[2], v0[3]); w.z = pk2(v1[0], v1[1]); w.w = pk2(v1[2], v1[3]);
                    const int h = (pn - 6) * 4 + bj * 2 + (wc >> 1), kk = wc & 1;
                    bf16_t* dst = isk ? kbase + (size_t)((unsigned)h * hstride + koff + (unsigned)(kk * 16 * 32 + 8 * fq)) : rowp + bj * 128;
                    *(u32x4*)dst = w;
                }
            }
    }
};

constexpr int PH_PER_LAYER = 7, N_PHASES = 2 + PH_PER_LAYER * DEPTH;
__device__ __forceinline__ void run_phase(const Args& a, LAS unsigned char* lds, int ph) {
    if (ph == 0) { phase_adaln(a, lds); convert_layer_weights(a, lds, 0); return; }
    if (ph == 1) { phase_rows(a, lds, -1, 0); return; }
    const int layer = (ph - 2) / PH_PER_LAYER, k = (ph - 2) % PH_PER_LAYER;
#ifndef REPK
#define REPK -1
#endif
    const int nrep = (k == REPK) ? 2 : 1;
    for (int rep = 0; rep < nrep; ++rep) {
    if (k == 0) {
        pg8::Gemm g{(const pg8::bf16_t*)(a.ws + WS_H), (const pg8::bf16_t*)(a.ws + WS_WIN), TT, NU, DM}; pg8::StaticOrder S; S.init(TT, NU, (int)gridDim.x, (int)blockIdx.x);
        EpiU E{(bf16_t*)(a.ws + WS_U), (bf16_t*)(a.ws + WS_KB)};
        pg8::gemm_phase<EpiU, pg8::StaticOrder>(lds, g, S, E, nullptr);
    } else if (k == 1) phase_prep(a, lds, layer);
    else if (k == 2) phase_s1(a, lds, layer);
    else if (k == 3) { if (rep == 0) phase_scan(a); }
    else if (k == 4) phase_mix(a, lds, layer, rep);
    else if (k == 5) {
        const int mrows = (layer == DEPTH - 1) ? TL : TT;
        pg8::Gemm g{(const pg8::bf16_t*)(a.ws + WS_H), (const pg8::bf16_t*)(a.ws + WS_WOUT), mrows, DM, DM}; pg8::StaticOrder S; S.init(mrows, DM, (int)gridDim.x, (int)blockIdx.x);
        pg8::EpiBf16<0> E{(pg8::bf16_t*)(a.ws + WS_U), DM, nullptr, 0, 0};
        pg8::gemm_phase<pg8::EpiBf16<0>, pg8::StaticOrder>(lds, g, S, E, nullptr);
        if (rep == 0 && layer + 1 < DEPTH) convert_win_queued(a, lds, layer + 1, (unsigned*)(a.ws + WS_BAR + 16384) + layer * 64 + 48);
    } else if (rep == 0) {
        if (REPK == 6) { phase_rows(a, lds, -1, layer + 1 < DEPTH ? layer + 1 : 0); __syncthreads(); }
        phase_rows(a, lds, layer, layer + 1 < DEPTH ? layer + 1 : -1);
        if (layer + 1 < DEPTH) { __syncthreads(); convert_wT(a.w_out + (size_t)(layer + 1) * 1024 * 1024, 1024, 1024, (bf16_t*)(a.ws + WS_WOUT), lds); }
    }
    if (REPK >= 0) __syncthreads();
    }
}

template <bool COOP>
__global__ void __launch_bounds__(512) mk_fwd(Args a) {
    extern __shared__ __attribute__((aligned(16))) unsigned char lds_raw[];
    LAS unsigned char* lds = (LAS unsigned char*)lds_raw;
    XcdBarrier bar; bar.bar = nullptr; bar.x = 0; bar.st = nullptr;
    if (COOP) {
        volatile LAS unsigned* stw = (volatile LAS unsigned*)(lds + LDS_BYTES - 16);
        if (threadIdx.x == 0) { stw[0] = 0u; stw[1] = 0u; }
        __syncthreads();
        bar = xcd_barrier_post((unsigned*)(a.ws + WS_BAR), stw);
    }
    for (int ph = a.ph_lo; ph < a.ph_hi; ++ph) {
        run_phase(a, lds, ph);
        if (COOP) {
            if (ph + 1 < a.ph_hi) { if (a.ph_lo > 0 && ph == a.ph_lo) cg::this_grid().sync(); else xcd_barrier(bar); }
        } else __syncthreads();
    }
}

extern "C" void kernel_launch(void* const* d_in, const int* in_sizes, int n_in, void* d_out, int out_size, void* d_ws, size_t ws_size, hipStream_t stream) {
    static int grid = 0;
    if (grid == 0) {
        if (n_in != 20 || ws_size < WS_END) { fprintf(stderr, "kernel_launch: unexpected n_in %d or ws_size %zu (< %zu)\n", n_in, ws_size, (size_t)WS_END); grid = -1; return; }
        int dev = 0, cus = 0, per_cu = 0;
        hipGetDevice(&dev); hipDeviceGetAttribute(&cus, hipDeviceAttributeMultiprocessorCount, dev);
        hipFuncSetAttribute((const void*)mk_fwd<true>, hipFuncAttributeMaxDynamicSharedMemorySize, LDS_BYTES);
        hipFuncSetAttribute((const void*)mk_fwd<false>, hipFuncAttributeMaxDynamicSharedMemorySize, LDS_BYTES);
        hipOccupancyMaxActiveBlocksPerMultiprocessor(&per_cu, (const void*)mk_fwd<true>, 512, LDS_BYTES);
        if (per_cu < 1) { fprintf(stderr, "kernel_launch: occupancy query reports %d blocks per CU\n", per_cu); per_cu = 1; }
        (void)hipGetLastError();
        grid = cus * 1;
        if (grid <= 0) grid = 256;
    }
    if (grid < 0) return;
    Args a{};
    a.x = (const float*)d_in[0]; a.c = (const float*)d_in[1]; a.ctx = (const float*)d_in[2]; a.c_ctx = (const float*)d_in[3]; a.w_ada = (const float*)d_in[4];
    a.b_ada = (const float*)d_in[5]; a.g_pre = (const float*)d_in[6]; a.g_post = (const float*)d_in[7]; a.w_in = (const float*)d_in[8]; a.conv_a_w = (const float*)d_in[9];
    a.rpb = (const float*)d_in[10]; a.ssd_conv_w = (const float*)d_in[11]; a.ssd_conv_b = (const float*)d_in[12]; a.dt_bias_f = (const float*)d_in[13];
    a.dt_bias_b = (const float*)d_in[14]; a.a_log_f = (const float*)d_in[15]; a.a_log_b = (const float*)d_in[16]; a.ssd_d = (const float*)d_in[17];
    a.ssd_norm_w = (const float*)d_in[18]; a.w_out = (const float*)d_in[19];
    a.out = (float*)d_out; a.ws = (unsigned char*)d_ws;
    if (hipMemsetAsync((char*)d_ws + WS_BAR, 0, 16384 + 1024, stream) != hipSuccess) { fprintf(stderr, "kernel_launch: memset of barrier words failed\n"); return; }
#if MK_ONE_LAUNCH
    a.ph_lo = 0; a.ph_hi = N_PHASES;
    void* args[] = {&a};
    hipError_t e = hipLaunchCooperativeKernel((const void*)mk_fwd<true>, dim3(grid), dim3(512), args, LDS_BYTES, stream);
    if (e != hipSuccess) fprintf(stderr, "cooperative launch failed: %s (grid %d)\n", hipGetErrorString(e), grid);
#else
    for (int ph = 0; ph < N_PHASES; ++ph) {
        a.ph_lo = ph; a.ph_hi = ph + 1;
        hipLaunchKernelGGL(mk_fwd<false>, dim3(grid), dim3(512), LDS_BYTES, stream, a);
    }
#endif
}
```
